# Optimizing an MI355X kernel written in HIP

```python
import math
import jax, jax.numpy as jnp
from jax import lax
import numpy as np

D_MODEL = 4096
BATCH = 1
SEQ = 8192
DEPTH = 1

N_Q_HEADS = 32
N_KV_HEADS = 8
HEAD_DIM = 128
ATTN_WIDTH = N_Q_HEADS * HEAD_DIM
KV_WIDTH = N_KV_HEADS * HEAD_DIM
WINDOW = 128
BLOCK = WINDOW
ROPE_DIM = HEAD_DIM // 4
ROPE_THETA = 500000.0
SSM_WIDTH = D_MODEL // 2
SSM_GROUP = 16
SSM_GROUPS = SSM_WIDTH // SSM_GROUP
SSM_STATE = 64
DT_MIN = 0.001
DT_MAX = 0.1
D_FF = 4 * D_MODEL
N_BRANCHES = 2
IN_WIDTH = ATTN_WIDTH + 2 * KV_WIDTH + SSM_WIDTH + N_BRANCHES * D_MODEL
N_MOD = 6
EPS = 1e-6
MASK_VALUE = -1e30

kernel_name = "hybrid_swa_sinks_s5_gated_adaln_block"


def rmsnorm(x, g):
    xf = x.astype(jnp.float32)
    y = xf * lax.rsqrt(jnp.mean(xf * xf, axis=-1, keepdims=True) + EPS)
    return (y * g.astype(jnp.float32)).astype(x.dtype)


def partial_rope(x, positions):
    half = ROPE_DIM // 2
    inv_freq = jnp.power(jnp.float32(ROPE_THETA), -2.0 * jnp.arange(half, dtype=jnp.float32) / ROPE_DIM)
    ang = positions.astype(jnp.float32)[..., None] * inv_freq
    cos = jnp.cos(ang)[:, :, None, :]
    sin = jnp.sin(ang)[:, :, None, :]
    xf = x.astype(jnp.float32)
    x1 = xf[..., :half]
    x2 = xf[..., half:ROPE_DIM]
    rot = jnp.concatenate([x1 * cos - x2 * sin, x2 * cos + x1 * sin], axis=-1)
    return jnp.concatenate([rot.astype(x.dtype), x[..., ROPE_DIM:]], axis=-1)


def sliding_window_attention(q, k, v, sinks):
    b, s = q.shape[0], q.shape[1]
    nb = s // BLOCK
    rep = N_Q_HEADS // N_KV_HEADS
    qb = q.reshape(b, nb, BLOCK, N_KV_HEADS, rep, HEAD_DIM)

    def band(t):
        tb = t.reshape(b, nb, BLOCK, N_KV_HEADS, HEAD_DIM)
        prev = jnp.pad(tb[:, :-1], ((0, 0), (1, 0), (0, 0), (0, 0), (0, 0)))
        return jnp.concatenate([prev, tb], axis=2)

    kb = band(k)
    vb = band(v)
    scores = jnp.einsum('bnqgrd,bnkgd->bngrqk', qb, kb).astype(jnp.float32) * (HEAD_DIM ** -0.5)

    blk = jnp.arange(nb)[:, None]
    q_idx = blk * BLOCK + jnp.arange(BLOCK)[None, :]
    k_idx = (blk - 1) * BLOCK + jnp.arange(2 * BLOCK)[None, :]
    rel = q_idx[:, :, None] - k_idx[:, None, :]
    valid = (rel >= 0) & (rel < WINDOW) & (k_idx[:, None, :] >= 0)
    scores = jnp.where(valid[None, :, None, None], scores, MASK_VALUE)

    sink = sinks.astype(jnp.float32).reshape(1, 1, N_KV_HEADS, rep, 1, 1)
    m = jnp.maximum(jnp.max(scores, axis=-1, keepdims=True), sink)
    p = jnp.exp(scores - m)
    denom = jnp.sum(p, axis=-1, keepdims=True) + jnp.exp(sink - m)
    probs = (p / denom).astype(vb.dtype)
    out = jnp.einsum('bngrqk,bnkgd->bnqgrd', probs, vb)
    return out.reshape(b, s, ATTN_WIDTH)


def _complex_scan_op(e1, e2):
    a1r, a1i, b1r, b1i = e1
    a2r, a2i, b2r, b2i = e2
    ar = a2r * a1r - a2i * a1i
    ai = a2r * a1i + a2i * a1r
    br = a2r * b1r - a2i * b1i + b2r
    bi = a2r * b1i + a2i * b1r + b2i
    return (ar, ai, br, bi)


def s5_layer(u, lam_re, lam_im, log_dt, b_re, b_im, c_re, c_im, d_skip):
    bsz, s = u.shape[0], u.shape[1]
    uf = u.astype(jnp.float32).reshape(bsz, s, SSM_GROUPS, SSM_GROUP)
    lr = lam_re.astype(jnp.float32)
    li = lam_im.astype(jnp.float32)
    dt = jnp.exp(log_dt.astype(jnp.float32))[:, None]
    mag = jnp.exp(lr * dt)
    abar_re = mag * jnp.cos(li * dt)
    abar_im = mag * jnp.sin(li * dt)
    den = lr * lr + li * li
    nr = abar_re - 1.0
    coef_re = (nr * lr + abar_im * li) / den
    coef_im = (abar_im * lr - nr * li) / den
    br_ = b_re.astype(jnp.float32)
    bi_ = b_im.astype(jnp.float32)
    bbar_re = coef_re[:, :, None] * br_ - coef_im[:, :, None] * bi_
    bbar_im = coef_re[:, :, None] * bi_ + coef_im[:, :, None] * br_
    bu_re = jnp.einsum('bsgc,gpc->bsgp', uf, bbar_re)
    bu_im = jnp.einsum('bsgc,gpc->bsgp', uf, bbar_im)
    a_re = jnp.broadcast_to(abar_re, bu_re.shape)
    a_im = jnp.broadcast_to(abar_im, bu_im.shape)
    _, _, st_re, st_im = lax.associative_scan(_complex_scan_op, (a_re, a_im, bu_re, bu_im), axis=1)
    y = (jnp.einsum('bsgp,gcp->bsgc', st_re, c_re.astype(jnp.float32))
         - jnp.einsum('bsgp,gcp->bsgc', st_im, c_im.astype(jnp.float32))
         + d_skip.astype(jnp.float32).reshape(SSM_GROUPS, SSM_GROUP) * uf)
    return y.reshape(bsz, s, SSM_WIDTH).astype(u.dtype)


def setup_inputs(seed: int = 0) -> dict:
    key = jax.random.key(seed)
    ks = jax.random.split(key, 24)
    f32 = jnp.float32
    L = DEPTH
    x = jax.random.normal(ks[0], (BATCH, SEQ, D_MODEL), f32)
    c = jax.random.normal(ks[1], (BATCH, D_MODEL), f32)
    offset = jax.random.randint(ks[2], (BATCH, 1), 0, 1024, dtype=jnp.int32)
    positions = offset + jnp.arange(SEQ, dtype=jnp.int32)[None, :]
    w_ada = jax.random.normal(ks[3], (L, D_MODEL, N_MOD * D_MODEL), f32) * (0.5 * D_MODEL ** -0.5)
    b_ada = jax.random.normal(ks[4], (L, N_MOD * D_MODEL), f32) * 0.02
    norm1_g = 1.0 + 0.02 * jax.random.normal(ks[5], (L, D_MODEL), f32)
    norm2_g = 1.0 + 0.02 * jax.random.normal(ks[6], (L, D_MODEL), f32)
    w_in = jax.random.normal(ks[7], (L, D_MODEL, IN_WIDTH), f32) * D_MODEL ** -0.5
    q_norm_g = 1.0 + 0.02 * jax.random.normal(ks[8], (L, HEAD_DIM), f32)
    k_norm_g = 1.0 + 0.02 * jax.random.normal(ks[9], (L, HEAD_DIM), f32)
    attn_sinks = jax.random.normal(ks[10], (L, N_Q_HEADS), f32)
    n = jnp.arange(SSM_STATE, dtype=f32)
    ssm_lam_re = jnp.broadcast_to(jnp.full((SSM_STATE,), -0.5, f32), (L, SSM_GROUPS, SSM_STATE))
    ssm_lam_im = jnp.broadcast_to(jnp.float32(math.pi) * n, (L, SSM_GROUPS, SSM_STATE))
    ssm_log_dt = jax.random.uniform(ks[11], (L, SSM_GROUPS), f32, math.log(DT_MIN), math.log(DT_MAX))
    b_std = (2.0 * SSM_GROUP) ** -0.5
    ssm_b_re = jax.random.normal(ks[12], (L, SSM_GROUPS, SSM_STATE, SSM_GROUP), f32) * b_std
    ssm_b_im = jax.random.normal(ks[13], (L, SSM_GROUPS, SSM_STATE, SSM_GROUP), f32) * b_std
    c_std = (2.0 * SSM_STATE) ** -0.5
    ssm_c_re = jax.random.normal(ks[14], (L, SSM_GROUPS, SSM_GROUP, SSM_STATE), f32) * c_std
    ssm_c_im = jax.random.normal(ks[15], (L, SSM_GROUPS, SSM_GROUP, SSM_STATE), f32) * c_std
    ssm_d = jax.random.normal(ks[16], (L, SSM_WIDTH), f32)
    w_glu = jax.random.normal(ks[17], (L, SSM_WIDTH, 2 * D_MODEL), f32) * SSM_WIDTH ** -0.5
    w_out = jax.random.normal(ks[18], (L, D_MODEL, D_MODEL), f32) * D_MODEL ** -0.5
    w_ff1 = jax.random.normal(ks[19], (L, D_MODEL, D_FF), f32) * D_MODEL ** -0.5
    w_ff2 = jax.random.normal(ks[20], (L, D_FF, D_MODEL), f32) * D_FF ** -0.5
    return {"x": x, "c": c, "positions": positions, "w_ada": w_ada, "b_ada": b_ada,
            "norm1_g": norm1_g, "norm2_g": norm2_g, "w_in": w_in, "q_norm_g": q_norm_g,
            "k_norm_g": k_norm_g, "attn_sinks": attn_sinks, "ssm_lam_re": ssm_lam_re,
            "ssm_lam_im": ssm_lam_im, "ssm_log_dt": ssm_log_dt, "ssm_b_re": ssm_b_re,
            "ssm_b_im": ssm_b_im, "ssm_c_re": ssm_c_re, "ssm_c_im": ssm_c_im, "ssm_d": ssm_d,
            "w_glu": w_glu, "w_out": w_out, "w_ff1": w_ff1, "w_ff2": w_ff2}


def reference(x, c, positions, w_ada, b_ada, norm1_g, norm2_g, w_in, q_norm_g, k_norm_g,
              attn_sinks, ssm_lam_re, ssm_lam_im, ssm_log_dt, ssm_b_re, ssm_b_im, ssm_c_re,
              ssm_c_im, ssm_d, w_glu, w_out, w_ff1, w_ff2):
    bsz, s = x.shape[0], x.shape[1]
    c_act = jax.nn.silu(c)
    for l in range(DEPTH):
        mod = (c_act @ w_ada[l] + b_ada[l])[:, None, :]
        sh1, sc1, g1, sh2, sc2, g2 = jnp.split(mod, N_MOD, axis=-1)

        h = rmsnorm(x, norm1_g[l]) * (1.0 + sc1) + sh1
        proj = h @ w_in[l]
        o1 = ATTN_WIDTH
        o2 = o1 + KV_WIDTH
        o3 = o2 + KV_WIDTH
        o4 = o3 + SSM_WIDTH
        q = proj[..., :o1].reshape(bsz, s, N_Q_HEADS, HEAD_DIM)
        k = proj[..., o1:o2].reshape(bsz, s, N_KV_HEADS, HEAD_DIM)
        v = proj[..., o2:o3].reshape(bsz, s, N_KV_HEADS, HEAD_DIM)
        u = proj[..., o3:o4]
        gate_a = proj[..., o4:o4 + D_MODEL]
        gate_s = proj[..., o4 + D_MODEL:]

        q = partial_rope(rmsnorm(q, q_norm_g[l]), positions)
        k = partial_rope(rmsnorm(k, k_norm_g[l]), positions)
        attn = sliding_window_attention(q, k, v, attn_sinks[l])

        y_ssm = s5_layer(u, ssm_lam_re[l], ssm_lam_im[l], ssm_log_dt[l], ssm_b_re[l], ssm_b_im[l],
                         ssm_c_re[l], ssm_c_im[l], ssm_d[l])
        glu = jax.nn.gelu(y_ssm) @ w_glu[l]
        ssm_branch = glu[..., :D_MODEL] * jax.nn.sigmoid(glu[..., D_MODEL:])

        merged = jax.nn.sigmoid(gate_a) * attn + jax.nn.sigmoid(gate_s) * ssm_branch
        x = x + g1 * (merged @ w_out[l])

        h2 = rmsnorm(x, norm2_g[l]) * (1.0 + sc2) + sh2
        ff = jnp.square(jax.nn.relu(h2 @ w_ff1[l])) @ w_ff2[l]
        x = x + g2 * ff
    return x
```

```cpp
#include <hip/hip_runtime.h>
#include <cstdio>
#include <cstdint>
namespace pg8 {
#define PG8_LAS __attribute__((address_space(3)))
typedef unsigned short bf16_t;
typedef short bf16x8 __attribute__((ext_vector_type(8)));
typedef float f32x4 __attribute__((ext_vector_type(4)));
typedef unsigned u32x4 __attribute__((ext_vector_type(4)));
typedef unsigned u32x2 __attribute__((ext_vector_type(2)));
typedef int i32x4 __attribute__((ext_vector_type(4)));
typedef int i32x8 __attribute__((ext_vector_type(8)));
constexpr int BM = 256, BK = 64, HALF = 128, HTB = HALF * BK * 2  , STAGE_BYTES = 8 * HTB, NXCD = 8, WGM = 8;

__host__ __device__ __forceinline__ int lds_byte(int r, int c) { const int st = (r >> 4) * 2 + (c >> 5), rr = r & 15, cc = c & 31, ob = rr * 64 + cc * 2; return st * 1024 + (ob ^ (((ob >> 9) & 1) << 5)); }
__host__ __device__ __forceinline__ void stage_rc(int b, int& R, int& C) { const int st = b / 1024, sb = b % 1024, swz = sb ^ (((sb >> 9) & 1) << 5); R = (st >> 1) * 16 + swz / 64; C = (st & 1) * 32 + (swz % 64) / 2; }
__host__ __device__ __forceinline__ int f8swz(int r) { return ((r >> 1) & 1) | (((r >> 3) & 1) << 2); }
__host__ __device__ __forceinline__ int lds_byte8(int r, int c) { return (r >> 4) * 2048 + (r & 15) * 128 + ((c ^ f8swz(r & 15)) << 4); }
__host__ __device__ __forceinline__ void stage_rc8(int b, int& R, int& Cb) { const int grp = b >> 11, r = (b >> 7) & 15, slot = (b >> 4) & 7; R = grp * 16 + r; Cb = (slot ^ f8swz(r)) << 4; }
__host__ __device__ __forceinline__ int perm32(int rho) { const int n = rho >> 4, i = rho & 15; return 8 * (i >> 2) + 4 * n + (i & 3); }

struct Unit { int pm, pn; };
struct Gemm { const bf16_t* A; const bf16_t* Bt; int M, N, K; };

struct StaticOrder {
    int nM, nN, nwg, G, c;
    __host__ __device__ __forceinline__ void init(int M, int N, int G_, int c_) { nM = M / BM; nN = N / BM; nwg = nM * nN; G = G_; c = c_; }
    __host__ __device__ __forceinline__ bool next(int i, Unit& u) const {
        const long L = (long)i * G + c; if (L >= nwg) return false;
        int wgid = (int)L; { const int q = nwg / NXCD, r = nwg % NXCD, xcd = wgid % NXCD, off = wgid / NXCD; wgid = (xcd < r ? xcd * (q + 1) : r * (q + 1) + (xcd - r) * q) + off; }
        const int nig = WGM * nN, gid = wgid / nig, fm = gid * WGM, gsz = (nM - fm) < WGM ? (nM - fm) : WGM;
        u.pm = fm + ((wgid % nig) % gsz); u.pn = (wgid % nig) / gsz; return true;
    }
    __device__ __forceinline__ void a_ready(const Unit&) const {}
    __device__ __forceinline__ void done(const Unit&) const {}
};


typedef float f32x2 __attribute__((ext_vector_type(2)));
typedef __bf16 bf16x2_t __attribute__((ext_vector_type(2)));
__device__ __forceinline__ unsigned cvt_pk_bf16(float lo, float hi) { f32x2 v = {lo, hi}; bf16x2_t b = __builtin_convertvector(v, bf16x2_t); return __builtin_bit_cast(unsigned, b); }
__device__ __forceinline__ float bf_lo(unsigned w) { return __uint_as_float(w << 16); }
__device__ __forceinline__ float bf_hi(unsigned w) { return __uint_as_float(w & 0xffff0000u); }
__device__ __forceinline__ unsigned pk4_i8(float a, float b, float c, float d) {
    const int ia = (int)__builtin_rintf(fminf(fmaxf(a, -127.f), 127.f)), ib = (int)__builtin_rintf(fminf(fmaxf(b, -127.f), 127.f)), ic = (int)__builtin_rintf(fminf(fmaxf(c, -127.f), 127.f)), id = (int)__builtin_rintf(fminf(fmaxf(d, -127.f), 127.f));
    return (unsigned)(ia & 255) | ((unsigned)(ib & 255) << 8) | ((unsigned)(ic & 255) << 16) | ((unsigned)(id & 255) << 24);
}
__device__ __forceinline__ unsigned pk4_u8(float a, float b, float c, float d) {
    const unsigned ua = (unsigned)(a * 255.0f + 0.5f), ub = (unsigned)(b * 255.0f + 0.5f), uc = (unsigned)(c * 255.0f + 0.5f), ud = (unsigned)(d * 255.0f + 0.5f);
    return ua | (ub << 8) | (uc << 16) | (ud << 24); }
__device__ __forceinline__ float u8f(unsigned w, int i) { return (float)((w >> (8 * i)) & 0xffu); }
__device__ __forceinline__ float sigmoidf_fast(float x) { return __builtin_amdgcn_rcpf(1.0f + __builtin_amdgcn_exp2f(-1.4426950408889634f * x)); }

__device__ __forceinline__ unsigned pk4_fp8(float a, float b, float c, float d) {
    a = fminf(fmaxf(a, -448.f), 448.f); b = fminf(fmaxf(b, -448.f), 448.f); c = fminf(fmaxf(c, -448.f), 448.f); d = fminf(fmaxf(d, -448.f), 448.f);
    int w = 0; w = __builtin_amdgcn_cvt_pk_fp8_f32(a, b, w, false); w = __builtin_amdgcn_cvt_pk_fp8_f32(c, d, w, true); return (unsigned)w;
}
constexpr float W8_SCALE = 128.0f;
constexpr float QSCALE = 0.08838834764831845f * 1.4426950408889634f;

struct EpiProj {
    static constexpr bool PERM = false, AFTER_DRAIN = false;
    bf16_t *Q, *K, *V; unsigned char *GA, *GS;     const float *qg, *kg, *rope; PG8_LAS float* xch;
    __device__ __forceinline__ void operator()(f32x4 (&acc)[2][2][4][2], const Unit& u, int wr, int wc, int fr, int fq) const {
        constexpr float DS = 1.0f / W8_SCALE;
        const int row0 = u.pm * BM + wr * 64 + fr; const int pn = u.pn;
        if (pn < 20) {
            const bool isq = pn < 16; const int head0 = isq ? 2 * pn : 2 * (pn - 16); bf16_t* dst = isq ? Q : K; const int ld = isq ? 4096 : 1024;
            const float* gain = isq ? qg : kg; const float osc = isq ? QSCALE : 1.0f;
#pragma unroll
            for (int ai = 0; ai < 2; ++ai)
#pragma unroll
                for (int m = 0; m < 4; ++m)
#pragma unroll
                    for (int bj = 0; bj < 2; ++bj) {
                        const f32x4 a0 = acc[ai][bj][m][0] * DS, a1 = acc[ai][bj][m][1] * DS;
                        float ss = (a0[0] * a0[0] + a0[1] * a0[1]) + (a0[2] * a0[2] + a0[3] * a0[3]) + (a1[0] * a1[0] + a1[1] * a1[1]) + (a1[2] * a1[2] + a1[3] * a1[3]);
                        ss += __shfl_xor(ss, 16); ss += __shfl_xor(ss, 32);
                        if (fq == 0) xch[((ai * HALF + wr * 64 + m * 16 + fr) * 2 + bj) * 4 + wc] = ss;
                    }
            asm volatile("s_waitcnt lgkmcnt(0)" ::: "memory"); __builtin_amdgcn_s_barrier(); asm volatile("" ::: "memory");
            f32x4 gv[2];
#pragma unroll
            for (int n = 0; n < 2; ++n) gv[n] = *(const f32x4*)(gain + 32 * wc + 16 * n + 4 * fq);
#pragma unroll
            for (int ai = 0; ai < 2; ++ai) {
                f32x4 csv[4], snv[4];
                if (wc == 0) {
#pragma unroll
                    for (int m = 0; m < 4; ++m) { const size_t row = (size_t)(u.pm * BM + ai * HALF + wr * 64 + m * 16 + fr);
                        csv[m] = *(const f32x4*)(rope + row * 32 + 4 * fq); snv[m] = *(const f32x4*)(rope + row * 32 + 16 + 4 * fq); }
                }
#pragma unroll
                for (int m = 0; m < 4; ++m) {
                    const int rl = ai * HALF + wr * 64 + m * 16 + fr; const size_t row = (size_t)(u.pm * BM + rl);
                    f32x4 cs = {1.f, 1.f, 1.f, 1.f}, sn = {0.f, 0.f, 0.f, 0.f};
                    if (wc == 0) { cs = csv[m]; sn = snv[m]; }
#pragma unroll
                    for (int bj = 0; bj < 2; ++bj) {
                        const f32x4 t = *(const PG8_LAS f32x4*)(xch + (rl * 2 + bj) * 4);
                        const float tot = (t[0] + t[1]) + (t[2] + t[3]);
                        const float rstd = 1.0f / sqrtf(tot * (1.0f / 128.0f) + 1e-6f);
                        f32x4 y0 = acc[ai][bj][m][0] * (DS * rstd) * gv[0], y1 = acc[ai][bj][m][1] * (DS * rstd) * gv[1];
                        if (wc == 0) { const f32x4 r0 = y0 * cs - y1 * sn, r1 = y1 * cs + y0 * sn; y0 = r0; y1 = r1; }
                        y0 = y0 * osc; y1 = y1 * osc;
                        u32x4 w; w.x = cvt_pk_bf16(y0[0], y0[1]); w.y = cvt_pk_bf16(y0[2], y0[3]); w.z = cvt_pk_bf16(y1[0], y1[1]); w.w = cvt_pk_bf16(y1[2], y1[3]);
                        *(u32x4*)(dst + row * ld + (head0 + bj) * 128 + 32 * wc + 8 * fq) = w;
                    }
                }
                asm volatile("" ::: "memory");
            }
        } else if (pn < 24) {
            const int col0 = (pn - 20) * BM + wc * 32 + 8 * fq;
#pragma unroll
            for (int ai = 0; ai < 2; ++ai)
#pragma unroll
                for (int m = 0; m < 4; ++m) { bf16_t* rowp = V + (size_t)(row0 + ai * HALF + m * 16) * 1024 + col0;
#pragma unroll
                    for (int bj = 0; bj < 2; ++bj) { const f32x4 v0 = acc[ai][bj][m][0] * DS, v1 = acc[ai][bj][m][1] * DS;
                        u32x4 w; w.x = cvt_pk_bf16(v0[0], v0[1]); w.y = cvt_pk_bf16(v0[2], v0[3]); w.z = cvt_pk_bf16(v1[0], v1[1]); w.w = cvt_pk_bf16(v1[2], v1[3]);
                        *(u32x4*)(rowp + bj * HALF) = w; } }
        } else {
            unsigned char* dst = pn < 40 ? GA : GS; const int col0 = ((pn - 24) & 15) * BM + wc * 32 + 8 * fq;
#pragma unroll
            for (int ai = 0; ai < 2; ++ai)
#pragma unroll
                for (int m = 0; m < 4; ++m) { unsigned char* rowp = dst + (size_t)(row0 + ai * HALF + m * 16) * 4096 + col0;
#pragma unroll
                    for (int bj = 0; bj < 2; ++bj) { f32x4 v0 = acc[ai][bj][m][0] * DS, v1 = acc[ai][bj][m][1] * DS;
#pragma unroll
                        for (int j = 0; j < 4; ++j) { v0[j] = sigmoidf_fast(v0[j]); v1[j] = sigmoidf_fast(v1[j]); }
                        u32x2 w; w.x = pk4_u8(v0[0], v0[1], v0[2], v0[3]); w.y = pk4_u8(v1[0], v1[1], v1[2], v1[3]);
                        *(u32x2*)(rowp + bj * HALF) = w; } }
        }
    }
};

__device__ __forceinline__ f32x4 i32_to_f32(const f32x4 a) { const i32x4 v = __builtin_bit_cast(i32x4, a); return (f32x4){(float)v[0], (float)v[1], (float)v[2], (float)v[3]}; }
struct EpiU {
    static constexpr bool PERM = false, AFTER_DRAIN = false;
    bf16_t* U; const float* sa; const unsigned* wmax;
    __device__ __forceinline__ void operator()(const f32x4 (&acc)[2][2][4][2], const Unit& u, int wr, int wc, int fr, int fq) const {
        const int row0 = u.pm * BM + wr * 64 + fr, col0 = u.pn * BM + wc * 32 + 8 * fq;
        f32x4 sw[2][2];
#pragma unroll
        for (int bj = 0; bj < 2; ++bj)
#pragma unroll
            for (int n = 0; n < 2; ++n) { const u32x4 w = *(const u32x4*)(wmax + col0 + bj * HALF + 4 * n);
                sw[bj][n] = (f32x4){__uint_as_float(w.x), __uint_as_float(w.y), __uint_as_float(w.z), __uint_as_float(w.w)} * (1.0f / 127.0f); }
#pragma unroll
        for (int ai = 0; ai < 2; ++ai)
#pragma unroll
            for (int m = 0; m < 4; ++m) { const int row = row0 + ai * HALF + m * 16; bf16_t* rowp = U + (size_t)row * 2048 + col0; const float s = sa[row];
#pragma unroll
                for (int bj = 0; bj < 2; ++bj) { const f32x4 v0 = i32_to_f32(acc[ai][bj][m][0]) * (sw[bj][0] * s), v1 = i32_to_f32(acc[ai][bj][m][1]) * (sw[bj][1] * s);
                    u32x4 w; w.x = cvt_pk_bf16(v0[0], v0[1]); w.y = cvt_pk_bf16(v0[2], v0[3]); w.z = cvt_pk_bf16(v1[0], v1[1]); w.w = cvt_pk_bf16(v1[2], v1[3]);
                    *(u32x4*)(rowp + bj * HALF) = w; } }
    }
};

struct EpiGlu {
    static constexpr bool PERM = false, AFTER_DRAIN = false;
    const unsigned char* GS; const bf16_t* ATT; unsigned char* MRG; float* mmax;
    __device__ __forceinline__ void operator()(const f32x4 (&acc)[2][2][4][2], const Unit& u, int wr, int wc, int fr, int fq) const {
        const int row0 = u.pm * BM + wr * 64 + fr; const int ch0 = u.pn * 128 + wc * 32 + 8 * fq;
        constexpr float DS = 1.0f / W8_SCALE;
        u32x2 gs[2][4]; u32x4 at[2][4];
#pragma unroll
        for (int ai = 0; ai < 2; ++ai)
#pragma unroll
            for (int m = 0; m < 4; ++m) { const size_t off = (size_t)(row0 + ai * HALF + m * 16) * 4096 + ch0; gs[ai][m] = *(const u32x2*)(GS + off); at[ai][m] = *(const u32x4*)(ATT + off); }
#pragma unroll
        for (int ai = 0; ai < 2; ++ai) {
#pragma unroll
            for (int m = 0; m < 4; ++m) {
                const size_t off = (size_t)(row0 + ai * HALF + m * 16) * 4096 + ch0;
                float mv[8]; float am = 0.f;
#pragma unroll
                for (int q = 0; q < 4; ++q) {
                    const int n = q >> 1, j = 2 * (q & 1);
                    const float v0 = acc[ai][0][m][n][j] * DS, v1 = acc[ai][0][m][n][j + 1] * DS, g0 = acc[ai][1][m][n][j] * DS, g1 = acc[ai][1][m][n][j + 1] * DS;
                    const float s0 = v0 * sigmoidf_fast(g0), s1 = v1 * sigmoidf_fast(g1);
                    const float m0 = bf_lo(at[ai][m][q]) + u8f(gs[ai][m][n], j) * (s0 * (1.0f / 255.0f)), m1 = bf_hi(at[ai][m][q]) + u8f(gs[ai][m][n], j + 1) * (s1 * (1.0f / 255.0f));
                    am = fmaxf(am, fmaxf(fabsf(m0), fabsf(m1)));
                    mv[2 * q] = m0; mv[2 * q + 1] = m1;
                }
                am = fmaxf(am, __shfl_xor(am, 16)); am = fmaxf(am, __shfl_xor(am, 32));
                const float iq = am > 0.f ? 127.0f * __builtin_amdgcn_rcpf(am) : 0.f;
                u32x2 w; w.x = pk4_i8(mv[0] * iq, mv[1] * iq, mv[2] * iq, mv[3] * iq); w.y = pk4_i8(mv[4] * iq, mv[5] * iq, mv[6] * iq, mv[7] * iq);
                *(u32x2*)(MRG + off) = w;
                if (fq == 0) mmax[(size_t)(row0 + ai * HALF + m * 16) * 128 + 4 * u.pn + wc] = am;
            }
        }
    }
};

template <bool NORM> struct EpiResid {
    static constexpr bool PERM = false, AFTER_DRAIN = false;
    const float* xin; const bf16_t* x1b_in; float* out; const float* gate; bf16_t* x1b_out; float* ssq; const float* sa; const unsigned* wmax;
    __device__ __forceinline__ void operator()(const f32x4 (&acc)[2][2][4][2], const Unit& u, int wr, int wc, int fr, int fq) const {
        const int row0 = u.pm * BM + wr * 64 + fr, col0 = u.pn * BM + wc * 32 + 8 * fq;
        f32x4 gv[2][2];
#pragma unroll
        for (int bj = 0; bj < 2; ++bj)
#pragma unroll
            for (int n = 0; n < 2; ++n) gv[bj][n] = *(const f32x4*)(gate + col0 + bj * HALF + 4 * n);
        if constexpr (NORM) {
#pragma unroll
            for (int bj = 0; bj < 2; ++bj)
#pragma unroll
                for (int n = 0; n < 2; ++n) { const u32x4 w = *(const u32x4*)(wmax + col0 + bj * HALF + 4 * n);
                    gv[bj][n] = gv[bj][n] * (f32x4){__uint_as_float(w.x), __uint_as_float(w.y), __uint_as_float(w.z), __uint_as_float(w.w)} * (1.0f / 127.0f); }
#pragma unroll
            for (int ai = 0; ai < 2; ++ai) {
                f32x4 bs[4][2][2];
#pragma unroll
                for (int m = 0; m < 4; ++m) { const size_t off = (size_t)(row0 + ai * HALF + m * 16) * 4096 + col0;
#pragma unroll
                    for (int bj = 0; bj < 2; ++bj)
#pragma unroll
                        for (int n = 0; n < 2; ++n) bs[m][bj][n] = *(const f32x4*)(xin + off + bj * HALF + 4 * n); }
#pragma unroll
                for (int m = 0; m < 4; ++m) { const int row = row0 + ai * HALF + m * 16; const size_t off = (size_t)row * 4096 + col0; float ss = 0.f; const float rs = sa[row];
#pragma unroll
                    for (int bj = 0; bj < 2; ++bj) { const f32x4 o0 = bs[m][bj][0] + gv[bj][0] * (i32_to_f32(acc[ai][bj][m][0]) * rs), o1 = bs[m][bj][1] + gv[bj][1] * (i32_to_f32(acc[ai][bj][m][1]) * rs);
                        ss += (o0[0] * o0[0] + o0[1] * o0[1]) + (o0[2] * o0[2] + o0[3] * o0[3]) + (o1[0] * o1[0] + o1[1] * o1[1]) + (o1[2] * o1[2] + o1[3] * o1[3]);
                        u32x4 w; w.x = cvt_pk_bf16(o0[0], o0[1]); w.y = cvt_pk_bf16(o0[2], o0[3]); w.z = cvt_pk_bf16(o1[0], o1[1]); w.w = cvt_pk_bf16(o1[2], o1[3]);
                        *(u32x4*)(x1b_out + off + bj * HALF) = w; }
                    ss += __shfl_xor(ss, 16); ss += __shfl_xor(ss, 32); if (fq == 0) ssq[(size_t)row * 64 + 4 * u.pn + wc] = ss; }
                asm volatile("" ::: "memory");
            }
        } else {
#pragma unroll
            for (int ai = 0; ai < 2; ++ai) {
                u32x4 bs[4][2];
#pragma unroll
                for (int m = 0; m < 4; ++m) { const size_t off = (size_t)(row0 + ai * HALF + m * 16) * 4096 + col0;
#pragma unroll
                    for (int bj = 0; bj < 2; ++bj) bs[m][bj] = *(const u32x4*)(x1b_in + off + bj * HALF); }
#pragma unroll
                for (int m = 0; m < 4; ++m) { const size_t off = (size_t)(row0 + ai * HALF + m * 16) * 4096 + col0;
#pragma unroll
                    for (int bj = 0; bj < 2; ++bj) { const u32x4 b = bs[m][bj];
                        const f32x4 x0 = {bf_lo(b.x), bf_hi(b.x), bf_lo(b.y), bf_hi(b.y)}, x1 = {bf_lo(b.z), bf_hi(b.z), bf_lo(b.w), bf_hi(b.w)};
                        *(f32x4*)(out + off + bj * HALF) = x0 + gv[bj][0] * acc[ai][bj][m][0]; *(f32x4*)(out + off + bj * HALF + 4) = x1 + gv[bj][1] * acc[ai][bj][m][1]; } }
                asm volatile("" ::: "memory");
            }
        }
    }
};

template <bool NORM> struct EpiRelu2 {
    static constexpr bool PERM = false, AFTER_DRAIN = false;
    bf16_t* O; int ldc; const PG8_LAS float* rstd; const float* bias;
    __device__ __forceinline__ void operator()(const f32x4 (&acc)[2][2][4][2], const Unit& u, int wr, int wc, int fr, int fq) const {
        const int row0 = u.pm * BM + wr * 64 + fr, col0 = u.pn * BM + wc * 32 + 8 * fq;
        f32x4 bv[2][2];
#pragma unroll
        for (int bj = 0; bj < 2; ++bj)
#pragma unroll
            for (int n = 0; n < 2; ++n) bv[bj][n] = NORM ? *(const f32x4*)(bias + col0 + bj * HALF + 4 * n) : (f32x4){0.f, 0.f, 0.f, 0.f};
#pragma unroll
        for (int ai = 0; ai < 2; ++ai)
#pragma unroll
            for (int m = 0; m < 4; ++m) { bf16_t* rowp = O + (size_t)(row0 + ai * HALF + m * 16) * ldc + col0;
                const float rs = NORM ? rstd[ai * HALF + wr * 64 + m * 16 + fr] : 1.0f;
#pragma unroll
                for (int bj = 0; bj < 2; ++bj) { f32x4 v0 = acc[ai][bj][m][0], v1 = acc[ai][bj][m][1];
                    if (NORM) { v0 = v0 * rs + bv[bj][0]; v1 = v1 * rs + bv[bj][1]; }
#pragma unroll
                    for (int j = 0; j < 4; ++j) { const float a = fmaxf(v0[j], 0.f), b = fmaxf(v1[j], 0.f); v0[j] = a * a; v1[j] = b * b; }
                    u32x4 w; w.x = cvt_pk_bf16(v0[0], v0[1]); w.y = cvt_pk_bf16(v0[2], v0[3]); w.z = cvt_pk_bf16(v1[0], v1[1]); w.w = cvt_pk_bf16(v1[2], v1[3]);
                    *(u32x4*)(rowp + bj * HALF) = w; } }
    }
};
template <class Epi, class Sched, bool ALIGN_EPI = false, bool SP2 = false, bool FP8 = false, bool I8 = false, bool SP4 = false>
__device__ __forceinline__ void gemm_phase(PG8_LAS unsigned char* lds, const Gemm g, const Sched& S, const Epi& E, const int wave_id  ) {
    int tid_ = wave_id * 64 + (int)__builtin_amdgcn_mbcnt_hi(~0u, __builtin_amdgcn_mbcnt_lo(~0u, 0u)); asm volatile("" : "+v"(tid_));
    const int tid = tid_, wid = __builtin_amdgcn_readfirstlane(tid >> 6), lane = tid & 63, wr = wid >> 2, wc = wid & 3, fr = lane & 15, fq = lane >> 4;
    const int K = g.K, nt = K / BK;
    unsigned voffA[2], voffB[2];
#pragma unroll
    for (int i = 0; i < 2; ++i) {
        if constexpr (FP8) { int R, Cb; stage_rc8(tid * 16 + i * 8192, R, Cb); voffA[i] = (unsigned)(R * K) * 2u + (unsigned)Cb; voffB[i] = voffA[i]; }
        else { int R, C; stage_rc(tid * 16 + i * 8192, R, C); const int Rb = Epi::PERM ? ((R & ~31) + perm32(R & 31)) : R;
            voffA[i] = (unsigned)(R * K + C) * 2u; voffB[i] = (unsigned)(Rb * K + C) * 2u; } }
    const size_t r64step = (size_t)64 * K * 2;
    const size_t kstep = (size_t)(BK * 2);
    const size_t hstep = (size_t)HALF * K * 2;
    const size_t tstep = 2 * hstep;
    const unsigned ldsw = (unsigned)wid * 1024u;
    const int aoff = lds_byte(wr * 64 + fr, fq * 8), boff = lds_byte(wc * 32 + fr, fq * 8);
    const int aoff8 = lds_byte8(wr * 64 + fr, 2 * fq), aoff8b = lds_byte8(wr * 64 + fr, 2 * fq + 1), boff8 = lds_byte8(wc * 32 + fr, 2 * fq), boff8b = lds_byte8(wc * 32 + fr, 2 * fq + 1);
#define PG8_SA(b, h) (((b) * 2 + (h)) * HTB)
#define PG8_SB(b, h) ((4 + (b) * 2 + (h)) * HTB)
#define PG8_STAGE(bufoff, gbase, voff) do { _Pragma("unroll") for (int _i = 0; _i < 2; ++_i)     \
        __builtin_amdgcn_global_load_lds((const unsigned*)((const char*)(gbase) + (size_t)_i * r64step + (voff)[0]), (PG8_LAS unsigned*)(lds + (bufoff) + ldsw + _i * 8192), 16, 0, 0); } while (0)
#define PG8_LDA(dst, b, h) do { _Pragma("unroll") for (int m = 0; m < 4; ++m) _Pragma("unroll") for (int k = 0; k < 2; ++k) dst[m][k] = *(const PG8_LAS bf16x8*)(lds + PG8_SA(b, h) + aoff + m * 2048 + k * 1024); } while (0)
#define PG8_LDB(dst, b, h) do { _Pragma("unroll") for (int n = 0; n < 2; ++n) _Pragma("unroll") for (int k = 0; k < 2; ++k) dst[n][k] = *(const PG8_LAS bf16x8*)(lds + PG8_SB(b, h) + boff + n * 2048 + k * 1024); } while (0)
#define PG8_MMA(ai, bj, At, Bt) do { __builtin_amdgcn_s_setprio(1); _Pragma("unroll") for (int m = 0; m < 4; ++m) _Pragma("unroll") for (int n = 0; n < 2; ++n) _Pragma("unroll") for (int k = 0; k < 2; ++k) \
        acc[ai][bj][m][n] = __builtin_amdgcn_mfma_f32_16x16x32_bf16(Bt[n][k], At[m][k], acc[ai][bj][m][n], 0, 0, 0); __builtin_amdgcn_s_setprio(0); } while (0)
#define PG8_LDA8(dst, b, h) do { _Pragma("unroll") for (int m = 0; m < 4; ++m) { const PG8_LAS unsigned char* p_ = lds + PG8_SA(b, h) + aoff8 + m * 2048; \
        dst[m] = __builtin_shufflevector(*(const PG8_LAS i32x4*)p_, *(const PG8_LAS i32x4*)(lds + PG8_SA(b, h) + aoff8b + m * 2048), 0, 1, 2, 3, 4, 5, 6, 7); } } while (0)
#define PG8_LDB8(dst, b, h) do { _Pragma("unroll") for (int n = 0; n < 2; ++n) { const PG8_LAS unsigned char* p_ = lds + PG8_SB(b, h) + boff8 + n * 2048; \
        dst[n] = __builtin_shufflevector(*(const PG8_LAS i32x4*)p_, *(const PG8_LAS i32x4*)(lds + PG8_SB(b, h) + boff8b + n * 2048), 0, 1, 2, 3, 4, 5, 6, 7); } } while (0)
#define PG8_MMA8(ai, bj, At, Bt) do { __builtin_amdgcn_s_setprio(1); _Pragma("unroll") for (int m = 0; m < 4; ++m) _Pragma("unroll") for (int n = 0; n < 2; ++n) \
        asm volatile("v_mfma_scale_f32_16x16x128_f8f6f4 %0, %1, %2, %0, %3, %3 op_sel_hi:[0,0,0]" : "+v"(acc[ai][bj][m][n]) : "v"(Bt[n]), "v"(At[m]), "v"(one8)); __builtin_amdgcn_s_setprio(0); } while (0)
#define PG8_MMAI(ai, bj, At, Bt) do { __builtin_amdgcn_s_setprio(1); _Pragma("unroll") for (int m = 0; m < 4; ++m) _Pragma("unroll") for (int n = 0; n < 2; ++n) _Pragma("unroll") for (int k = 0; k < 2; ++k) \
        asm volatile("v_mfma_i32_16x16x64_i8 %0, %1, %2, %0" : "+v"(acc[ai][bj][m][n]) : "v"(Bt[n][k]), "v"(At[m][k])); __builtin_amdgcn_s_setprio(0); } while (0)
#define PG8_WAIT_V(n) asm volatile("s_waitcnt vmcnt(" #n ")" ::: "memory")
#define PG8_WAIT_L(n) asm volatile("s_waitcnt lgkmcnt(" #n ")" ::: "memory")
#define PG8_BAR __builtin_amdgcn_s_barrier()
#define PG8_SCHED __builtin_amdgcn_sched_barrier(0)
    Unit cur, nxt; int ui = 0;
    if (!S.next(0, cur)) return;
    f32x4 acc[2][2][4][2];
#pragma unroll
    for (int a = 0; a < 2; ++a)
#pragma unroll
        for (int b = 0; b < 2; ++b)
#pragma unroll
            for (int m = 0; m < 4; ++m)
#pragma unroll
                for (int n = 0; n < 2; ++n) acc[a][b][m][n] = (f32x4){0.f, 0.f, 0.f, 0.f};
    bf16x8 At[4][2], B0[2][2], B1[2][2];
    bf16x8 At1[4][2];
    int one8 = 0x7F7F7F7F; if constexpr (FP8) asm volatile("" : "+v"(one8));
    i32x8 At8[4], B08[2], B18[2];
    const char* cA = (const char*)g.A + (size_t)cur.pm * tstep; const char* cB = (const char*)g.Bt + (size_t)cur.pn * tstep;
    S.a_ready(cur);
#define PG8_STAGE4(b, pa, pb) do { PG8_STAGE(PG8_SB(b, 0), pb, voffB); PG8_STAGE(PG8_SB(b, 1), (pb) + hstep, voffB); PG8_STAGE(PG8_SA(b, 0), pa, voffA); PG8_STAGE(PG8_SA(b, 1), (pa) + hstep, voffA); } while (0)
#define PG8_MMAX(ai, bj, A_, B_) do { if constexpr (I8) PG8_MMAI(ai, bj, A_, B_); else PG8_MMA(ai, bj, A_, B_); } while (0)
    if constexpr (SP4) {
        PG8_STAGE4(0, cA, cB);
        if (wr == 1) { PG8_STAGE4(1, cA + kstep, cB + kstep); PG8_BAR; PG8_WAIT_V(8); } else { PG8_WAIT_V(0); }
        PG8_BAR; PG8_BAR;
    } else
    if constexpr (SP2) {
        PG8_STAGE(PG8_SB(0, 0), cB, voffB); PG8_STAGE(PG8_SB(0, 1), cB + hstep, voffB); PG8_STAGE(PG8_SA(0, 0), cA, voffA); PG8_STAGE(PG8_SA(0, 1), cA + hstep, voffA);
        if (wr == 1) PG8_BAR;
        PG8_WAIT_V(2); PG8_BAR;
        PG8_STAGE(PG8_SB(1, 0), cB + kstep, voffB); PG8_STAGE(PG8_SA(1, 0), cA + kstep, voffA); PG8_STAGE(PG8_SB(1, 1), cB + hstep + kstep, voffB);
        PG8_WAIT_V(6); PG8_BAR;
    } else {
        PG8_STAGE(PG8_SB(0, 0), cB, voffB); PG8_STAGE(PG8_SA(0, 0), cA, voffA); PG8_STAGE(PG8_SB(0, 1), cB + hstep, voffB); PG8_STAGE(PG8_SA(0, 1), cA + hstep, voffA);
        if (wr == 1) PG8_BAR;
        PG8_WAIT_V(4); PG8_BAR;
        PG8_STAGE(PG8_SB(1, 0), cB + kstep, voffB); PG8_STAGE(PG8_SA(1, 0), cA + kstep, voffA); PG8_STAGE(PG8_SB(1, 1), cB + hstep + kstep, voffB);
        PG8_WAIT_V(6); PG8_BAR;
    }
    for (;;) {
        const bool has_next = S.next(ui + 1, nxt);
        const char* nA = has_next ? (const char*)g.A + (size_t)nxt.pm * tstep : cA; const char* nB = has_next ? (const char*)g.Bt + (size_t)nxt.pn * tstep : cB;
        for (int t = 0; t < nt; t += 2) {
            const bool last = (t == nt - 2);
            const char* a1 = cA + (size_t)(t + 1) * kstep; const char* b1x = cB + (size_t)(t + 1) * kstep;
            const char* a2 = last ? nA : cA + (size_t)(t + 2) * kstep; const char* b2 = last ? nB : cB + (size_t)(t + 2) * kstep;
            const char* a3 = a2 + kstep; const char* b3 = b2 + kstep;
            if (last && has_next) S.a_ready(nxt);
            if constexpr (SP4) {
            PG8_LDB(B0, 0, 0); PG8_LDB(B1, 0, 1); PG8_SCHED; PG8_LDA(At, 0, 0); PG8_LDA(At1, 0, 1);
            if (wr == 0) PG8_STAGE4(1, a1, b1x);
            PG8_WAIT_L(0); if (wr == 1) PG8_WAIT_V(0); PG8_BAR;
            if (wr == 1) PG8_STAGE4(0, a2, b2);
            PG8_MMAX(0, 0, At, B0); PG8_MMAX(0, 1, At, B1); PG8_MMAX(1, 0, At1, B0); PG8_MMAX(1, 1, At1, B1);
            if (wr == 0) PG8_WAIT_V(0); PG8_BAR; PG8_SCHED;
            PG8_LDB(B0, 1, 0); PG8_LDB(B1, 1, 1); PG8_SCHED; PG8_LDA(At, 1, 0); PG8_LDA(At1, 1, 1);
            if (wr == 0) PG8_STAGE4(0, a2, b2);
            PG8_WAIT_L(0); if (wr == 1) PG8_WAIT_V(0); PG8_BAR;
            if (wr == 1) PG8_STAGE4(1, a3, b3);
            PG8_MMAX(0, 0, At, B0); PG8_MMAX(0, 1, At, B1); PG8_MMAX(1, 0, At1, B0); PG8_MMAX(1, 1, At1, B1);
            if (wr == 0) PG8_WAIT_V(0); PG8_BAR; PG8_SCHED;
            } else
            if constexpr (SP2) {
            if constexpr (FP8) {
            PG8_LDB8(B08, 0, 0); PG8_LDB8(B18, 0, 1); PG8_SCHED; PG8_LDA8(At8, 0, 0); PG8_STAGE(PG8_SA(1, 1), a1 + hstep, voffA);
            PG8_WAIT_V(8); PG8_WAIT_L(0); PG8_BAR; PG8_MMA8(0, 0, At8, B08); PG8_MMA8(0, 1, At8, B18); PG8_BAR; PG8_SCHED;
            PG8_LDA8(At8, 0, 1); PG8_STAGE(PG8_SB(0, 0), b2, voffB); PG8_STAGE(PG8_SB(0, 1), b2 + hstep, voffB); PG8_STAGE(PG8_SA(0, 0), a2, voffA);
            PG8_WAIT_V(8); PG8_WAIT_L(0); PG8_BAR; PG8_MMA8(1, 0, At8, B08); PG8_MMA8(1, 1, At8, B18); PG8_BAR; PG8_SCHED;
            PG8_LDB8(B08, 1, 0); PG8_LDB8(B18, 1, 1); PG8_SCHED; PG8_LDA8(At8, 1, 0); PG8_STAGE(PG8_SA(0, 1), a2 + hstep, voffA);
            PG8_WAIT_V(8); PG8_WAIT_L(0); PG8_BAR; PG8_MMA8(0, 0, At8, B08); PG8_MMA8(0, 1, At8, B18); PG8_BAR; PG8_SCHED;
            PG8_LDA8(At8, 1, 1); PG8_STAGE(PG8_SB(1, 0), b3, voffB); PG8_STAGE(PG8_SB(1, 1), b3 + hstep, voffB); PG8_STAGE(PG8_SA(1, 0), a3, voffA);
            PG8_WAIT_V(8); PG8_WAIT_L(0); PG8_BAR; PG8_MMA8(1, 0, At8, B08); PG8_MMA8(1, 1, At8, B18); PG8_BAR; PG8_SCHED;
            } else if constexpr (I8) {
            PG8_LDB(B0, 0, 0); PG8_LDB(B1, 0, 1); PG8_SCHED; PG8_LDA(At, 0, 0); PG8_STAGE(PG8_SA(1, 1), a1 + hstep, voffA);
            PG8_WAIT_V(8); PG8_WAIT_L(0); PG8_BAR; PG8_MMAI(0, 0, At, B0); PG8_MMAI(0, 1, At, B1); PG8_BAR; PG8_SCHED;
            PG8_LDA(At, 0, 1); PG8_STAGE(PG8_SB(0, 0), b2, voffB); PG8_STAGE(PG8_SB(0, 1), b2 + hstep, voffB); PG8_STAGE(PG8_SA(0, 0), a2, voffA);
            PG8_WAIT_V(8); PG8_WAIT_L(0); PG8_BAR; PG8_MMAI(1, 0, At, B0); PG8_MMAI(1, 1, At, B1); PG8_BAR; PG8_SCHED;
            PG8_LDB(B0, 1, 0); PG8_LDB(B1, 1, 1); PG8_SCHED; PG8_LDA(At, 1, 0); PG8_STAGE(PG8_SA(0, 1), a2 + hstep, voffA);
            PG8_WAIT_V(8); PG8_WAIT_L(0); PG8_BAR; PG8_MMAI(0, 0, At, B0); PG8_MMAI(0, 1, At, B1); PG8_BAR; PG8_SCHED;
            PG8_LDA(At, 1, 1); PG8_STAGE(PG8_SB(1, 0), b3, voffB); PG8_STAGE(PG8_SB(1, 1), b3 + hstep, voffB); PG8_STAGE(PG8_SA(1, 0), a3, voffA);
            PG8_WAIT_V(8); PG8_WAIT_L(0); PG8_BAR; PG8_MMAI(1, 0, At, B0); PG8_MMAI(1, 1, At, B1); PG8_BAR; PG8_SCHED;
            } else {
            PG8_LDB(B0, 0, 0); PG8_LDB(B1, 0, 1); PG8_SCHED; PG8_LDA(At, 0, 0); PG8_STAGE(PG8_SA(1, 1), a1 + hstep, voffA);
            PG8_WAIT_V(8); PG8_WAIT_L(0); PG8_BAR; PG8_MMA(0, 0, At, B0); PG8_MMA(0, 1, At, B1); PG8_BAR; PG8_SCHED;
            PG8_LDA(At, 0, 1); PG8_STAGE(PG8_SB(0, 0), b2, voffB); PG8_STAGE(PG8_SB(0, 1), b2 + hstep, voffB); PG8_STAGE(PG8_SA(0, 0), a2, voffA);
            PG8_WAIT_V(8); PG8_WAIT_L(0); PG8_BAR; PG8_MMA(1, 0, At, B0); PG8_MMA(1, 1, At, B1); PG8_BAR; PG8_SCHED;
            PG8_LDB(B0, 1, 0); PG8_LDB(B1, 1, 1); PG8_SCHED; PG8_LDA(At, 1, 0); PG8_STAGE(PG8_SA(0, 1), a2 + hstep, voffA);
            PG8_WAIT_V(8); PG8_WAIT_L(0); PG8_BAR; PG8_MMA(0, 0, At, B0); PG8_MMA(0, 1, At, B1); PG8_BAR; PG8_SCHED;
            PG8_LDA(At, 1, 1); PG8_STAGE(PG8_SB(1, 0), b3, voffB); PG8_STAGE(PG8_SB(1, 1), b3 + hstep, voffB); PG8_STAGE(PG8_SA(1, 0), a3, voffA);
            PG8_WAIT_V(8); PG8_WAIT_L(0); PG8_BAR; PG8_MMA(1, 0, At, B0); PG8_MMA(1, 1, At, B1); PG8_BAR; PG8_SCHED;
            }
            } else {
            PG8_LDB(B0, 0, 0); PG8_SCHED; PG8_LDA(At, 0, 0); PG8_STAGE(PG8_SA(1, 1), a1 + hstep, voffA);
            PG8_WAIT_L(8); PG8_BAR; PG8_WAIT_L(0); PG8_MMA(0, 0, At, B0); PG8_BAR; PG8_SCHED;
            PG8_LDB(B1, 0, 1); PG8_STAGE(PG8_SB(0, 0), b2, voffB);
            PG8_BAR; PG8_WAIT_L(0); PG8_MMA(0, 1, At, B1); PG8_BAR;
            PG8_LDA(At, 0, 1); PG8_STAGE(PG8_SA(0, 0), a2, voffA);
            PG8_BAR; PG8_WAIT_L(0); PG8_MMA(1, 0, At, B0); PG8_BAR; PG8_SCHED;
            PG8_STAGE(PG8_SB(0, 1), b2 + hstep, voffB);
            PG8_WAIT_V(6); PG8_BAR; PG8_MMA(1, 1, At, B1); PG8_BAR;
            PG8_LDB(B0, 1, 0); PG8_SCHED; PG8_LDA(At, 1, 0); PG8_STAGE(PG8_SA(0, 1), a2 + hstep, voffA);
            PG8_WAIT_L(8); PG8_BAR; PG8_WAIT_L(0); PG8_MMA(0, 0, At, B0); PG8_BAR; PG8_SCHED;
            PG8_LDB(B1, 1, 1); PG8_STAGE(PG8_SB(1, 0), b3, voffB);
            PG8_BAR; PG8_WAIT_L(0); PG8_MMA(0, 1, At, B1); PG8_BAR;
            PG8_LDA(At, 1, 1); PG8_STAGE(PG8_SA(1, 0), a3, voffA);
            PG8_BAR; PG8_WAIT_L(0); PG8_MMA(1, 0, At, B0); PG8_BAR; PG8_SCHED;
            PG8_STAGE(PG8_SB(1, 1), b3 + hstep, voffB);
            PG8_WAIT_V(6); PG8_BAR; PG8_MMA(1, 1, At, B1); PG8_BAR;
            }
        }
        if constexpr (ALIGN_EPI) { if (wr == 0) PG8_BAR; }
        if constexpr (!Epi::AFTER_DRAIN) { int l2_ = (int)__builtin_amdgcn_mbcnt_hi(~0u, __builtin_amdgcn_mbcnt_lo(~0u, 0u)); asm volatile("" : "+v"(l2_));
            E(acc, cur, wr, wc, l2_ & 15, l2_ >> 4); S.done(cur); }
        if (!has_next) break;
#pragma unroll
        for (int a = 0; a < 2; ++a)
#pragma unroll
            for (int b = 0; b < 2; ++b)
#pragma unroll
                for (int m = 0; m < 4; ++m)
#pragma unroll
                    for (int n = 0; n < 2; ++n) acc[a][b][m][n] = (f32x4){0.f, 0.f, 0.f, 0.f};
        cur = nxt; cA = nA; cB = nB; ++ui;
        if constexpr (ALIGN_EPI) { if (wr == 1) PG8_BAR; }
    }
    PG8_WAIT_V(0);
    if constexpr (!ALIGN_EPI) { if (wr == 0) PG8_BAR; }
    PG8_BAR;
    if constexpr (Epi::AFTER_DRAIN) { E.fused(acc, cur, wr, wc, fr, fq, lds, wid, lane); S.done(cur); }
#undef PG8_SA
#undef PG8_SB
#undef PG8_STAGE
#undef PG8_LDA
#undef PG8_LDB
#undef PG8_MMA
#undef PG8_LDA8
#undef PG8_LDB8
#undef PG8_MMA8
#undef PG8_MMAI
#undef PG8_STAGE4
#undef PG8_MMAX
#undef PG8_WAIT_V
#undef PG8_WAIT_L
#undef PG8_BAR
#undef PG8_SCHED
}
}

constexpr int SEQ = 8192, DM = 4096, NQH = 32, NKVH = 8, HD = 128, INW = 16384, DFF = 16384, SSMW = 2048, NGRP = 128, NST = 64, NMOD = 6 * DM;
constexpr float EPS = 1e-6f, LOG2E = 1.4426950408889634f;
constexpr int NWAVES = 8, NTHR = 512;

constexpr size_t MiB = 1u << 20;
constexpr size_t WS_CTL = 0, CTL_ZERO_BYTES = 1 * MiB;
constexpr size_t WS_MODP = 1 * MiB;
constexpr size_t WS_MOD = 2 * MiB;
constexpr size_t WS_ROPE = 3 * MiB;
constexpr size_t WS_F = 4 * MiB;
constexpr size_t WS_WIN = 16 * MiB, WS_WGLU = 144 * MiB, WS_WOUT = 176 * MiB, WS_WFF1 = 208 * MiB, WS_WFF2 = 336 * MiB;
constexpr size_t WS_H = 464 * MiB;
constexpr size_t WS_Q = 528 * MiB, WS_K = 592 * MiB, WS_V = 608 * MiB;
constexpr size_t WS_U = 624 * MiB;
constexpr size_t WS_GA = 688 * MiB, WS_GS = 752 * MiB;
constexpr size_t WS_ATT = 816 * MiB;
constexpr size_t WS_YG = 880 * MiB;
constexpr size_t WS_MRG = 912 * MiB;
constexpr size_t WS_FFH = 976 * MiB;
constexpr size_t WS_H8 = 1232 * MiB;
constexpr size_t WS_WG8 = WS_WIN;
constexpr size_t WS_WINU = WS_WIN + 64 * MiB;
constexpr size_t WS_HI8 = 1264 * MiB;
constexpr size_t WS_MRGI8 = 1296 * MiB;
constexpr size_t WS_MMAX = 1328 * MiB;
constexpr size_t WS_SAH = 1332 * MiB, WS_SAM = WS_SAH + 65536;
constexpr size_t WS_END = 1333 * MiB;
constexpr size_t WS_WMAXU = WS_CTL + 196608, WS_WMAXO = WS_CTL + 204800;
constexpr size_t WS_BIAS2 = WS_CTL + 65536;
constexpr size_t WS_SSQ = 12 * MiB;
constexpr int CW_BAR = 4096;

constexpr int RING_BYTES = 131072;
constexpr int XCH_OFF = RING_BYTES, XCH_BYTES = 8192;
constexpr int MISC_OFF = 147456;
constexpr int LDS_BYTES = MISC_OFF + 256;

#define GAS __attribute__((address_space(1)))
#define LAS __attribute__((address_space(3)))
typedef unsigned short bf16;
typedef unsigned u32x4 __attribute__((ext_vector_type(4)));
typedef unsigned u32x2 __attribute__((ext_vector_type(2)));
typedef float f32x4 __attribute__((ext_vector_type(4)));
typedef float f32x16 __attribute__((ext_vector_type(16)));
typedef short bf16x8 __attribute__((ext_vector_type(8)));
typedef short s16x4 __attribute__((ext_vector_type(4)));
typedef GAS unsigned gu32;
#define RLX_AGENT __ATOMIC_RELAXED, __HIP_MEMORY_SCOPE_AGENT
#define LDS_WAIT() asm volatile("s_waitcnt lgkmcnt(0)" ::: "memory")
#define VM_WAIT() asm volatile("s_waitcnt vmcnt(0)" ::: "memory")
using pg8::cvt_pk_bf16;
typedef float f32x2 __attribute__((ext_vector_type(2)));
#define XB_TMO      128
#define XB_XCNT(j)  (256  + 64 * (j))
#define XB_XSUB(j)  (1280 + 64 * (j))
#define XB_XGEN(j)  (2304 + 64 * (j))
#define XB_TOP      3328
#define XB_TOPGEN   3392
#define XCD_BAR_WORDS 3456
#define XB_SPIN_CAP (1u << 18)

__device__ __forceinline__ unsigned xb_ld(unsigned* p)              { return __hip_atomic_load(p, __ATOMIC_RELAXED, __HIP_MEMORY_SCOPE_AGENT); }
__device__ __forceinline__ unsigned xb_add(unsigned* p, unsigned v) { return __hip_atomic_fetch_add(p, v, __ATOMIC_RELAXED, __HIP_MEMORY_SCOPE_AGENT); }
__device__ __forceinline__ unsigned xb_xcc_id() { return (unsigned)__builtin_amdgcn_s_getreg((3 << 11) | 20) & 0xFu; }
#define XB_SPIN(cond, bar) do { unsigned _sp = 0; while (cond) { __builtin_amdgcn_s_sleep(1); \
    if ((++_sp & 255u) == 0u) { if (xb_ld(&(bar)[XB_TMO])) break; if (_sp > XB_SPIN_CAP) { atomicAdd(&(bar)[XB_TMO], 1u); break; } } } } while (0)

struct XcdBarrier {
    unsigned* bar; unsigned x; int wave;
    volatile LAS unsigned* st;
};

__device__ __forceinline__ int xb_lane_id() { return (int)__builtin_amdgcn_mbcnt_hi(~0u, __builtin_amdgcn_mbcnt_lo(~0u, 0u)); }
__device__ __forceinline__ XcdBarrier xcd_barrier_post(unsigned* bar, volatile LAS unsigned* st) {
    XcdBarrier b; b.bar = bar; b.x = xb_xcc_id(); b.st = st; b.wave = __builtin_amdgcn_readfirstlane((int)(threadIdx.x >> 6));
    if (threadIdx.x == 0) (void)xb_add(&bar[XB_XCNT(b.x)], 1u);
    return b;
}
__device__ __forceinline__ void xcd_barrier_complete(unsigned* bar, unsigned x, unsigned& nloc, unsigned& nx) {
    const unsigned G = gridDim.x * gridDim.y * gridDim.z;
    unsigned sum, cnt, mine, sp = 0u;
    for (;;) {
        sum = 0u; cnt = 0u; mine = 0u;
#pragma unroll
        for (unsigned j = 0; j < 16; ++j) { const unsigned c = xb_ld(&bar[XB_XCNT(j)]); sum += c; cnt += (c > 0u) ? 1u : 0u; mine = (j == x) ? c : mine; }
        if (sum == G) break;
        __builtin_amdgcn_s_sleep(1);
        if ((++sp & 255u) == 0u) { if (xb_ld(&bar[XB_TMO])) break; if (sp > XB_SPIN_CAP) { atomicAdd(&bar[XB_TMO], 1u); break; } }
    }
    nloc = mine > 0u ? mine : 1u; nx = cnt > 0u ? cnt : 1u;
}

__device__ __forceinline__ void xcd_barrier(const XcdBarrier& b) {
    asm volatile("s_waitcnt vmcnt(0)" ::: "memory");
    __syncthreads();
    if (b.wave == 0 && xb_lane_id() == 0) {
        unsigned* bar = b.bar;
        __builtin_amdgcn_s_waitcnt(0);
        unsigned nloc = b.st[0], nx = b.st[1];
        if (nloc == 0u) { xcd_barrier_complete(bar, b.x, nloc, nx); b.st[0] = nloc; b.st[1] = nx; }
        const unsigned old = xb_add(&bar[XB_XSUB(b.x)], 1u);
        const unsigned gen = old / nloc;
        if (old + 1u == (gen + 1u) * nloc) {
            __builtin_amdgcn_fence(__ATOMIC_RELEASE, "agent");
            asm volatile("s_waitcnt vmcnt(0)" ::: "memory");
            const unsigned og = xb_add(&bar[XB_TOP], 1u);
            const unsigned tg = og / nx;
            if (og + 1u == (tg + 1u) * nx) xb_add(&bar[XB_TOPGEN], 1u);
            else XB_SPIN(xb_ld(&bar[XB_TOPGEN]) == tg, bar);
            __builtin_amdgcn_fence(__ATOMIC_ACQUIRE, "agent");
            xb_add(&bar[XB_XGEN(b.x)], 1u);
            asm volatile("s_waitcnt vmcnt(0)" ::: "memory");
        } else {
            XB_SPIN(xb_ld(&bar[XB_XGEN(b.x)]) == gen, bar);
            __builtin_amdgcn_fence(__ATOMIC_ACQUIRE, "agent");
            asm volatile("s_waitcnt vmcnt(0)" ::: "memory");
        }
    }
    __syncthreads();
}

__device__ __forceinline__ float wave_sum(float v) {
#pragma unroll
    for (int o = 1; o < 64; o <<= 1) v += __shfl_xor(v, o);
    return v;
}
__device__ __forceinline__ int inv_perm32(int l) { return 16 * ((l >> 2) & 1) + 4 * (l >> 3) + (l & 3); }
template <int MODE> __device__ __forceinline__ int phys_row(int n) {
    if (MODE == 1 && n < 5120) return n;
    if (MODE == 2) { const int bj = n >> 12, ch = n & 4095; return 256 * (ch >> 7) + 128 * bj + (ch & 96) + inv_perm32(ch & 31); }
    return (n & ~31) + inv_perm32(n & 31);
}
using pg8::pk4_i8;
__device__ __forceinline__ float i8f(unsigned w, int i) { return (float)((int)(w << (24 - 8 * i)) >> 24); }
struct TrItem { const float* W; bf16* WT; int K, N, mode, k0, n0, fp8, i8; const unsigned* wmax; const float* addv; float* bias; const float* rowscale; };
__device__ __forceinline__ int phys_row_rt(int mode, int n) {
    if (mode == 1 && n < 5120) return n;
    if (mode == 2) { const int bj = n >> 12, ch = n & 4095; return 256 * (ch >> 7) + 128 * bj + (ch & 96) + inv_perm32(ch & 31); }
    return (n & ~31) + inv_perm32(n & 31);
}
__device__ __forceinline__ void tr_load(const TrItem& d, float (&v)[64], int lane) {
    const float* src = d.W + (size_t)d.k0 * d.N + d.n0 + lane;
#pragma unroll
    for (int i = 0; i < 64; ++i) v[i] = __builtin_nontemporal_load(src + (size_t)i * d.N);
}
__device__ __forceinline__ void tr_finish(const TrItem& d, const float (&v)[64], LAS float* scr, int lane) {
    if (d.bias) { float s = 0.f;
#pragma unroll
        for (int i = 0; i < 64; ++i) s += d.addv[d.k0 + i] * v[i];
        atomicAdd(d.bias + d.n0 + lane, s); }
    if (d.i8) {
        const float cm = __uint_as_float(d.wmax[(d.mode == 5 ? d.n0 - 6144 : d.n0) + lane]), inv = cm > 0.f ? 127.0f / cm : 0.f;
#pragma unroll
        for (int i = 0; i < 64; ++i) scr[i * 65 + lane] = v[i] * inv;
        LDS_WAIT();
        const int c8 = lane & 7;
#pragma unroll
        for (int j = 0; j < 8; ++j) { const int n = (lane >> 3) + 8 * j; const LAS float* s = scr + (8 * c8) * 65 + n;
            u32x2 o; o.x = pk4_i8(s[0 * 65], s[1 * 65], s[2 * 65], s[3 * 65]); o.y = pk4_i8(s[4 * 65], s[5 * 65], s[6 * 65], s[7 * 65]);
            const int row = d.mode == 5 ? phys_row_rt(0, d.n0 - 6144 + n) : phys_row_rt(d.mode, d.n0 + n);
            *(u32x2*)((unsigned char*)d.WT + (size_t)row * d.K + d.k0 + 8 * c8) = o; }
        LDS_WAIT(); return;
    }
    if (d.rowscale) {
#pragma unroll
        for (int i = 0; i < 64; ++i) scr[i * 65 + lane] = v[i] * d.rowscale[d.k0 + i];
    } else {
#pragma unroll
        for (int i = 0; i < 64; ++i) scr[i * 65 + lane] = v[i];
    }
    LDS_WAIT();
    const int c = lane & 7;
    if (d.fp8) {
#pragma unroll
        for (int j = 0; j < 8; ++j) { const int n = (lane >> 3) + 8 * j; const LAS float* s = scr + (8 * c) * 65 + n;
            u32x2 o; o.x = pg8::pk4_fp8(s[0 * 65] * pg8::W8_SCALE, s[1 * 65] * pg8::W8_SCALE, s[2 * 65] * pg8::W8_SCALE, s[3 * 65] * pg8::W8_SCALE);
            o.y = pg8::pk4_fp8(s[4 * 65] * pg8::W8_SCALE, s[5 * 65] * pg8::W8_SCALE, s[6 * 65] * pg8::W8_SCALE, s[7 * 65] * pg8::W8_SCALE);
            const int nn = d.n0 + n, row = d.mode != 3 ? phys_row_rt(d.mode, nn) : (nn < 6144 ? phys_row_rt(1, nn) : 6144 + phys_row_rt(0, nn - 8192));
            *(u32x2*)((unsigned char*)d.WT + (size_t)row * d.K + d.k0 + 8 * c) = o; }
        LDS_WAIT(); return;
    }
#pragma unroll
    for (int j = 0; j < 8; ++j) { const int n = (lane >> 3) + 8 * j; const LAS float* s = scr + (8 * c) * 65 + n;
        u32x4 o; o.x = cvt_pk_bf16(s[0 * 65], s[1 * 65]); o.y = cvt_pk_bf16(s[2 * 65], s[3 * 65]); o.z = cvt_pk_bf16(s[4 * 65], s[5 * 65]); o.w = cvt_pk_bf16(s[6 * 65], s[7 * 65]);
        const int row = d.mode == 5 ? phys_row_rt(0, d.n0 - 6144 + n) : phys_row_rt(d.mode, d.n0 + n);
        *(u32x4*)(d.WT + (size_t)row * d.K + d.k0 + 8 * c) = o; }
    LDS_WAIT();
}

struct Ptrs {
    const float *x, *c, *w_ada, *b_ada, *n1g, *n2g, *w_in, *qng, *kng, *sinks, *lam_re, *lam_im, *log_dt, *b_re, *b_im, *c_re, *c_im, *dsk, *w_glu, *w_out, *w_ff1, *w_ff2;
    const int* pos; float* out;
    float *MODP, *MOD, *ROPE, *F, *BIAS2, *SSQ;
    unsigned char *H8, *WG8, *HI8, *MRGI8; bf16* WINU; float *MMAX, *SAH, *SAM; unsigned *WMAXU, *WMAXO;
    bf16 *WIN, *WGLU, *WOUT, *WFF1, *WFF2, *H, *Q, *K, *V, *ATT, *YG, *FFH, *U; unsigned char *GA, *GS, *MRG;
};

constexpr int TI_IN = (DM / 64) * 224;
constexpr int TI_U = (DM / 64) * 32;
constexpr int TI_CM = TI_U + (DM / 64) * (DM / 64);
constexpr int TI_GLU = (SSMW / 64) * (2 * DM / 64), TI_OUT = (DM / 64) * (DM / 64), TI_FF1 = (DM / 64) * (DFF / 64), TI_FF2 = (DFF / 64) * (DM / 64), TI_ALL = TI_GLU + TI_OUT + TI_FF1 + TI_FF2;
template <int LIST> __device__ __forceinline__ TrItem tr_decode(const Ptrs& P, int r) {
    TrItem d; d.addv = nullptr; d.bias = nullptr; d.fp8 = 0; d.rowscale = nullptr; d.i8 = 0; d.wmax = nullptr;
    if (LIST == 0 || LIST == 2) { d.W = P.w_in; d.WT = P.WIN; d.K = DM; d.N = INW; d.mode = 1; }
    else if (r < TI_GLU) { d.W = P.w_glu; d.WT = P.WGLU; d.K = SSMW; d.N = 2 * DM; d.mode = 2; d.fp8 = 1; }
    else if (r < TI_GLU + TI_OUT) { r -= TI_GLU; d.W = P.w_out; d.WT = P.WOUT; d.K = DM; d.N = DM; d.mode = 0; d.i8 = 1; d.wmax = P.WMAXO; }
    else if (r < TI_GLU + TI_OUT + TI_FF1) { r -= TI_GLU + TI_OUT; d.W = P.w_ff1; d.WT = P.WFF1; d.K = DM; d.N = DFF; d.mode = 0; d.addv = P.MOD + 3 * DM; d.bias = P.BIAS2; d.rowscale = P.MOD + 6 * DM; }
    else { r -= TI_GLU + TI_OUT + TI_FF1; d.W = P.w_ff2; d.WT = P.WFF2; d.K = DFF; d.N = DM; d.mode = 0; }
    if (LIST == 0) { const int nb = r % 224; d.k0 = 64 * (r / 224); d.n0 = 64 * (nb < 96 ? nb : nb + 32); d.mode = 3; d.fp8 = 1; d.WT = (bf16*)P.WG8; }
    else if (LIST == 2) { d.k0 = 64 * (r / 32); d.n0 = 6144 + 64 * (r % 32); d.mode = 5; d.i8 = 1; d.wmax = P.WMAXU; d.WT = P.WINU; }
    else { const int nblk = d.N / 64; d.k0 = 64 * (r / nblk); d.n0 = 64 * (r % nblk); }
    return d;
}
__device__ __forceinline__ int pool_grab(LAS unsigned* ctr, int lo, int lane) {
    unsigned k = 0u; if (lane == 0) k = __hip_atomic_fetch_add(ctr, 1u, __ATOMIC_RELAXED, __HIP_MEMORY_SCOPE_WORKGROUP);
    return lo + (int)__builtin_amdgcn_readfirstlane(k);
}
template <int LIST> __device__ __forceinline__ void transpose_pool(const Ptrs& P, int lo, int hi, LAS unsigned* ctr, LAS float* scr, int lane) {
    float va[64], vb[64];
    int r0 = pool_grab(ctr, lo, lane); if (r0 >= hi) return;
    TrItem d0 = tr_decode<LIST>(P, r0), d1 = d0; tr_load(d0, va, lane);
    for (;;) {
        const int r1 = pool_grab(ctr, lo, lane);
        if (r1 < hi) { d1 = tr_decode<LIST>(P, r1); tr_load(d1, vb, lane); }
        tr_finish(d0, va, scr, lane);
        if (r1 >= hi) break;
        r0 = pool_grab(ctr, lo, lane);
        if (r0 < hi) { d0 = tr_decode<LIST>(P, r0); tr_load(d0, va, lane); }
        tr_finish(d1, vb, scr, lane);
        if (r0 >= hi) break;
    }
}

__device__ __forceinline__ void phase0(const Ptrs& P, LAS unsigned char* lds, int bx, int G, int tid, int wave, int lane) {
    LAS float* red = (LAS float*)lds;
    for (int j = bx; j < 32 * 8; j += G) {
        const int chunk = j & 31, kg = j >> 5, k0 = kg * 512 + wave * 64;
        float cv = P.c[k0 + lane]; cv = cv / (1.0f + expf(-cv));
        f32x4 acc0 = {0.f, 0.f, 0.f, 0.f}, acc1 = acc0, acc2 = acc0;
        const float* wp = P.w_ada + (size_t)k0 * NMOD + chunk * 768 + lane * 4;
#pragma unroll 8
        for (int kk = 0; kk < 64; ++kk) { const float* q = wp + (size_t)kk * NMOD;
            const f32x4 w0 = __builtin_nontemporal_load((const f32x4*)q), w1 = __builtin_nontemporal_load((const f32x4*)(q + 256)), w2 = __builtin_nontemporal_load((const f32x4*)(q + 512));
            const float a = __int_as_float(__builtin_amdgcn_readlane(__float_as_int(cv), kk)); acc0 += w0 * a; acc1 += w1 * a; acc2 += w2 * a; }
        *(LAS f32x4*)(red + wave * 768 + lane * 4) = acc0; *(LAS f32x4*)(red + wave * 768 + 256 + lane * 4) = acc1; *(LAS f32x4*)(red + wave * 768 + 512 + lane * 4) = acc2;
        __syncthreads();
        for (int c = tid; c < 768; c += NTHR) { float sm = 0.f;
#pragma unroll
            for (int w = 0; w < 8; ++w) sm += red[w * 768 + c];
            P.MODP[(size_t)kg * NMOD + chunk * 768 + c] = sm; }
        __syncthreads();
    }
    { const int gwc = bx * NWAVES + wave, NGWC = G * NWAVES;
      for (int it = gwc; it < TI_CM; it += NGWC) {
          const bool isu = it < TI_U; const int r = isu ? it : it - TI_U, nblk = isu ? 32 : DM / 64, N = isu ? INW : DM;
          const int k0 = 64 * (r / nblk), nb = r % nblk, n0 = isu ? 6144 + 64 * nb : 64 * nb;
          const float* src = (isu ? P.w_in : P.w_out) + (size_t)k0 * N + n0 + lane;
          float m0 = 0.f, m1 = 0.f;
#pragma unroll 16
          for (int i = 0; i < 64; i += 2) { m0 = fmaxf(m0, fabsf(__builtin_nontemporal_load(src + (size_t)i * N))); m1 = fmaxf(m1, fabsf(__builtin_nontemporal_load(src + (size_t)(i + 1) * N))); }
          atomicMax((isu ? P.WMAXU : P.WMAXO) + 64 * nb + lane, __float_as_uint(fmaxf(m0, m1)));
      } }
    { const int per = (TI_IN + G - 1) / G, lo = bx * per, hi = (lo + per < TI_IN) ? lo + per : TI_IN;
      transpose_pool<0>(P, lo, hi, (LAS unsigned*)(lds + MISC_OFF) + 18, (LAS float*)(lds + wave * 16640), lane); }
}

__device__ __forceinline__ void norm_row(const float* xrow, unsigned char* orow8, unsigned char* orowi, float* sa, const LAS float* mult, const LAS float* add, int lane) {
    const f32x4* xr = (const f32x4*)xrow + lane;
    f32x4 v[16]; float ss = 0.f;
#pragma unroll
    for (int j = 0; j < 16; ++j) { v[j] = xr[64 * j]; ss += (v[j][0] * v[j][0] + v[j][1] * v[j][1]) + (v[j][2] * v[j][2] + v[j][3] * v[j][3]); }
    const float rstd = 1.0f / sqrtf(wave_sum(ss) * (1.0f / DM) + EPS);
    float am = 0.f;
#pragma unroll
    for (int j = 0; j < 16; ++j) { const f32x4 m = *(const LAS f32x4*)(mult + 4 * lane + 256 * j), a = *(const LAS f32x4*)(add + 4 * lane + 256 * j);
        v[j] = v[j] * rstd * m + a; am = fmaxf(fmaxf(am, fmaxf(fabsf(v[j][0]), fabsf(v[j][1]))), fmaxf(fabsf(v[j][2]), fabsf(v[j][3])));
        if ((j & 3) == 3) asm volatile("" ::: "memory"); }
#pragma unroll
    for (int o = 1; o < 64; o <<= 1) am = fmaxf(am, __shfl_xor(am, o));
    const float inv = am > 0.f ? 127.0f / am : 0.f;
    if (lane == 0) *sa = am * (1.0f / 127.0f);
    unsigned* o4 = (unsigned*)orow8 + lane; unsigned* oi = (unsigned*)orowi + lane;
#pragma unroll
    for (int j = 0; j < 16; ++j) { const f32x4 y = v[j]; o4[64 * j] = pg8::pk4_fp8(y[0], y[1], y[2], y[3]); oi[64 * j] = pk4_i8(y[0] * inv, y[1] * inv, y[2] * inv, y[3] * inv); }
}
__device__ __forceinline__ void quant_row(const unsigned char* mrow, const float* pmax, unsigned char* orowi, float* sa, int lane) {
    float am = fmaxf(pmax[lane], pmax[64 + lane]);
#pragma unroll
    for (int o = 1; o < 64; o <<= 1) am = fmaxf(am, __shfl_xor(am, o));
    const float inv = am > 0.f ? 1.0f / am : 0.f;
    if (lane == 0) *sa = am * (1.0f / 127.0f);
    const u32x4* mr = (const u32x4*)mrow + lane; u32x4* oi = (u32x4*)orowi + lane;
    u32x4 w[4]; float f[4];
#pragma unroll
    for (int j = 0; j < 4; ++j) { w[j] = mr[64 * j]; f[j] = pmax[(lane >> 1) + 32 * j] * inv; }
#pragma unroll
    for (int j = 0; j < 4; ++j) { u32x4 o;
#pragma unroll
        for (int c = 0; c < 4; ++c) { const unsigned x = w[j][c]; o[c] = pk4_i8(i8f(x, 0) * f[j], i8f(x, 1) * f[j], i8f(x, 2) * f[j], i8f(x, 3) * f[j]); }
        oi[64 * j] = o; }
}

__device__ __forceinline__ void phase1(const Ptrs& P, LAS unsigned char* lds, int bx, int G, int tid, int wave, int lane) {
    LAS float* mult = (LAS float*)lds; LAS float* add = mult + DM;
    for (int c = tid; c < DM; c += NTHR) {
        float sh = P.b_ada[c], sc = P.b_ada[DM + c];
#pragma unroll
        for (int p = 0; p < 8; ++p) { sh += P.MODP[(size_t)p * NMOD + c]; sc += P.MODP[(size_t)p * NMOD + DM + c]; }
        mult[c] = P.n1g[c] * (1.0f + sc); add[c] = sh;
    }
    for (int col = bx * NTHR + tid; col < NMOD; col += G * NTHR) {
        float s = P.b_ada[col];
#pragma unroll
        for (int p = 0; p < 8; ++p) s += P.MODP[(size_t)p * NMOD + col];
        P.MOD[col] = s;
        if (col >= 4 * DM && col < 5 * DM) P.MOD[6 * DM + (col - 4 * DM)] = P.n2g[col - 4 * DM] * (1.0f + s);
    }
    const int gw = bx * NWAVES + wave, NGW = G * NWAVES;
    for (int r4 = gw; r4 < SEQ / 4; r4 += NGW) {
        const int row = r4 * 4 + (lane >> 4), i = lane & 15;
        const float inv_freq = powf(500000.0f, -2.0f * (float)i / 32.0f);
        const float ang = (float)P.pos[row] * inv_freq;
        P.ROPE[(size_t)row * 32 + i] = cosf(ang); P.ROPE[(size_t)row * 32 + 16 + i] = sinf(ang);
    }
    __syncthreads();
    for (int row = gw; row < SEQ; row += NGW) norm_row(P.x + (size_t)row * DM, P.H8 + (size_t)row * DM, P.HI8 + (size_t)row * DM, P.SAH + row, mult, add, lane);
    { const int per = (TI_U + G - 1) / G, lo = bx * per, hi = (lo + per < TI_U) ? lo + per : TI_U;
      __syncthreads();
      transpose_pool<2>(P, lo, hi, (LAS unsigned*)(lds + MISC_OFF) + 19, (LAS float*)(lds + wave * 16640), lane); }
}
__device__ __forceinline__ int crow(int r, int h) { return (r & 3) + 8 * (r >> 2) + 4 * h; }
#define MFMA32(a, b, c) __builtin_amdgcn_mfma_f32_32x32x16_bf16((a), (b), (c), 0, 0, 0)
#define MFMA16(a, b, c) __builtin_amdgcn_mfma_f32_16x16x32_bf16((a), (b), (c), 0, 0, 0)
constexpr int ATT_KP = 272, ATT_VP = 520, ATT_VOFF = 256 * ATT_KP;
static_assert(ATT_VOFF + 128 * ATT_VP <= MISC_OFF, "attention LDS");
__device__ __forceinline__ void attn_unit(const Ptrs& P, int qb, int kh, LAS unsigned char* lds, int tid, int wave, int lane) {
    const bool hasprev = qb > 0;
#pragma unroll
    for (int i = 0; i < 8; ++i) {
        const int c = tid + NTHR * i, key = c >> 4, part = c & 15; u32x4 v = {0u, 0u, 0u, 0u};
        if (hasprev || key >= 128) v = *(const u32x4*)(P.K + (size_t)(128 * (qb - 1) + key) * 1024 + kh * 128 + part * 8);
        *(LAS u32x4*)(lds + key * ATT_KP + part * 16) = v;
    }
#pragma unroll
    for (int i = 0; i < 8; ++i) {
        const int c = tid + NTHR * i, key = c & 255, part = c >> 8; u32x4 v = {0u, 0u, 0u, 0u};
        if (hasprev || key >= 128) v = *(const u32x4*)(P.V + (size_t)(128 * (qb - 1) + key) * 1024 + kh * 128 + part * 8);
#pragma unroll
        for (int e = 0; e < 8; ++e) *(LAS unsigned short*)(lds + ATT_VOFF + (part * 8 + e) * ATT_VP + key * 2) = (unsigned short)((v[e >> 1] >> (16 * (e & 1))) & 0xffffu);
    }
    __syncthreads();
    const int hq = 4 * kh + (wave >> 1), qh = wave & 1, r = lane & 31, h = lane >> 5;
    const float sink2 = P.sinks[hq] * LOG2E;
    const float NEG = -__builtin_inff();
#pragma unroll 1
    for (int qq = 0; qq < 2; ++qq) {
        const int i0 = 64 * qh + 32 * qq;
        const size_t qrow = (size_t)(128 * qb + i0 + r);
        bf16x8 qf[8];
#pragma unroll
        for (int ks = 0; ks < 8; ++ks) qf[ks] = *(const bf16x8*)(P.Q + qrow * 4096 + hq * 128 + 16 * ks + 8 * h);
        f32x16 st[5];
#pragma unroll
        for (int t = 0; t < 5; ++t) {
#pragma unroll
            for (int e = 0; e < 16; ++e) st[t][e] = 0.f;
#pragma unroll
            for (int ks = 0; ks < 8; ++ks) { const bf16x8 kf = *(const LAS bf16x8*)(lds + (i0 + 32 * t + r) * ATT_KP + (16 * ks + 8 * h) * 2); st[t] = MFMA32(kf, qf[ks], st[t]); }
        }
#pragma unroll
        for (int e = 0; e < 16; ++e) { const int cr = crow(e, h); if (cr <= r) st[0][e] = NEG; if (cr > r) st[4][e] = NEG; }
        if (!hasprev) {
#pragma unroll
            for (int t = 0; t < 5; ++t) if (i0 + 32 * t < 128) {
#pragma unroll
                for (int e = 0; e < 16; ++e) st[t][e] = NEG; }
        }
        float m = sink2;
#pragma unroll
        for (int t = 0; t < 5; ++t)
#pragma unroll
            for (int e = 0; e < 16; ++e) m = fmaxf(m, st[t][e]);
        m = fmaxf(m, __shfl_xor(m, 32));
        float l = 0.f;
#pragma unroll
        for (int t = 0; t < 5; ++t)
#pragma unroll
            for (int e = 0; e < 16; ++e) { const float p = __builtin_amdgcn_exp2f(st[t][e] - m); st[t][e] = p; l += p; }
        l += __shfl_xor(l, 32);
        l += __builtin_amdgcn_exp2f(sink2 - m);
        bf16x8 pf[5][2];
#pragma unroll
        for (int t = 0; t < 5; ++t)
#pragma unroll
            for (int s = 0; s < 2; ++s) { u32x4 w; w.x = cvt_pk_bf16(st[t][8 * s + 0], st[t][8 * s + 1]); w.y = cvt_pk_bf16(st[t][8 * s + 2], st[t][8 * s + 3]); w.z = cvt_pk_bf16(st[t][8 * s + 4], st[t][8 * s + 5]); w.w = cvt_pk_bf16(st[t][8 * s + 6], st[t][8 * s + 7]);
                pf[t][s] = __builtin_bit_cast(bf16x8, w); }
        const float inv = (1.0f / 255.0f) / l;
#pragma unroll
        for (int db = 0; db < 4; ++db) {
            f32x16 o;
#pragma unroll
            for (int e = 0; e < 16; ++e) o[e] = 0.f;
#pragma unroll
            for (int t = 0; t < 5; ++t)
#pragma unroll
                for (int s = 0; s < 2; ++s) {
                    const LAS unsigned char* vp = lds + ATT_VOFF + (32 * db + r) * ATT_VP + (i0 + 32 * t + 16 * s + 4 * h) * 2;
                    const s16x4 lo = *(const LAS s16x4*)vp, hi = *(const LAS s16x4*)(vp + 16);
                    const bf16x8 vf = __builtin_shufflevector(lo, hi, 0, 1, 2, 3, 4, 5, 6, 7);
                    o = MFMA32(vf, pf[t][s], o);
                }
            unsigned gav[4];
#pragma unroll
            for (int g4 = 0; g4 < 4; ++g4) gav[g4] = *(const unsigned*)(P.GA + qrow * 4096 + hq * 128 + 32 * db + 8 * g4 + 4 * h);
#pragma unroll
            for (int g4 = 0; g4 < 4; ++g4) { u32x2 w;
                w.x = cvt_pk_bf16(o[4 * g4 + 0] * inv * pg8::u8f(gav[g4], 0), o[4 * g4 + 1] * inv * pg8::u8f(gav[g4], 1)); w.y = cvt_pk_bf16(o[4 * g4 + 2] * inv * pg8::u8f(gav[g4], 2), o[4 * g4 + 3] * inv * pg8::u8f(gav[g4], 3));
                *(u32x2*)(P.ATT + qrow * 4096 + hq * 128 + 32 * db + 8 * g4 + 4 * h) = w; }
        }
    }
    __syncthreads();
}

constexpr int SSM_L = 512, SSM_NSC = SEQ / SSM_L;
constexpr int SSM_WL = 16640;
static_assert(NWAVES * SSM_WL <= MISC_OFF, "ssm LDS");
__device__ __forceinline__ void split_bf16(const f32x4 a, const f32x4 b, bf16x8& hi, bf16x8& lo) {
    u32x4 wh; wh.x = cvt_pk_bf16(a[0], a[1]); wh.y = cvt_pk_bf16(a[2], a[3]); wh.z = cvt_pk_bf16(b[0], b[1]); wh.w = cvt_pk_bf16(b[2], b[3]);
    f32x4 ra, rb; ra[0] = a[0] - pg8::bf_lo(wh.x); ra[1] = a[1] - pg8::bf_hi(wh.x); ra[2] = a[2] - pg8::bf_lo(wh.y); ra[3] = a[3] - pg8::bf_hi(wh.y);
    rb[0] = b[0] - pg8::bf_lo(wh.z); rb[1] = b[1] - pg8::bf_hi(wh.z); rb[2] = b[2] - pg8::bf_lo(wh.w); rb[3] = b[3] - pg8::bf_hi(wh.w);
    u32x4 wl; wl.x = cvt_pk_bf16(ra[0], ra[1]); wl.y = cvt_pk_bf16(ra[2], ra[3]); wl.z = cvt_pk_bf16(rb[0], rb[1]); wl.w = cvt_pk_bf16(rb[2], rb[3]);
    hi = __builtin_bit_cast(bf16x8, wh); lo = __builtin_bit_cast(bf16x8, wl);
}
template <bool PASS2> __device__ __forceinline__ void ssm_unit(const Ptrs& P, int sc, int g, LAS unsigned char* wl, int lane) {
    const int p = lane, fr = lane & 15, fq = lane >> 4;
    LAS float* R = (LAS float*)wl;
    const float dt = expf(P.log_dt[g]);
    const float lr = P.lam_re[g * NST + p], li = P.lam_im[g * NST + p];
    const float mag = expf(lr * dt), ar = mag * cosf(li * dt), ai = mag * sinf(li * dt);
    const float den = lr * lr + li * li, nr = ar - 1.0f;
    const float cre = (nr * lr + ai * li) / den, cim = (ai * lr - nr * li) / den;
#pragma unroll
    for (int q = 0; q < 4; ++q) { const f32x4 br = *(const f32x4*)(P.b_re + (size_t)(g * NST + p) * 16 + 4 * q), bi = *(const f32x4*)(P.b_im + (size_t)(g * NST + p) * 16 + 4 * q);
        *(LAS f32x4*)(R + p * 20 + 4 * q) = br * cre - bi * cim; *(LAS f32x4*)(R + (64 + p) * 20 + 4 * q) = bi * cre + br * cim; }
    LDS_WAIT();
    bf16x8 bhi[8], blo[8];
#pragma unroll
    for (int j = 0; j < 8; ++j) { const f32x4 a = *(const LAS f32x4*)(R + (16 * j + fr) * 20 + 8 * (fq & 1)), b = *(const LAS f32x4*)(R + (16 * j + fr) * 20 + 8 * (fq & 1) + 4);
        split_bf16(a, b, bhi[j], blo[j]); if (fq >= 2) blo[j] = (bf16x8){0, 0, 0, 0, 0, 0, 0, 0}; }
    LDS_WAIT();
    float sr = 0.f, si = 0.f;
    bf16x8 chi[4], clo[4]; f32x4 dv = {0.f, 0.f, 0.f, 0.f};
    if (PASS2) {
        float pr = ar, pi = ai;
#pragma unroll
        for (int k = 0; k < 9; ++k) { const float t = pr * pr - pi * pi; pi = 2.0f * pr * pi; pr = t; }
        const f32x2* Fp = (const f32x2*)P.F + (size_t)g * NST + p;
        for (int c0 = 0; c0 < sc; c0 += 8) {
            f32x2 f[8];
#pragma unroll
            for (int k = 0; k < 8; ++k) { f[k] = (f32x2){0.f, 0.f}; if (c0 + k < sc) f[k] = Fp[(size_t)(c0 + k) * NGRP * NST]; }
#pragma unroll
            for (int k = 0; k < 8; ++k) if (c0 + k < sc) { const float t = pr * sr - pi * si + f[k][0]; si = pr * si + pi * sr + f[k][1]; sr = t; }
        }
#pragma unroll
        for (int kk = 0; kk < 4; ++kk) { const float* cp = (kk < 2 ? P.c_re : P.c_im) + (size_t)(g * 16 + fr) * NST + 32 * (kk & 1) + 8 * fq;
            f32x4 a = *(const f32x4*)cp, b = *(const f32x4*)(cp + 4); if (kk >= 2) { a = -a; b = -b; }
            split_bf16(a, b, chi[kk], clo[kk]); }
        dv = *(const f32x4*)(P.dsk + 16 * g + 4 * fq);
    }
    const bf16* up = P.U + (size_t)(SSM_L * sc + fr) * SSMW + 16 * g;
    u32x4 uab = *(const u32x4*)(up + 8 * (fq & 1)); u32x2 uc = {0u, 0u};
    if (PASS2) uc = *(const u32x2*)(up + 4 * fq);
#pragma unroll 1
    for (int sb = 0; sb < SSM_L / 16; ++sb) {
        const bf16x8 af = fq < 2 ? __builtin_bit_cast(bf16x8, uab) : (bf16x8){0, 0, 0, 0, 0, 0, 0, 0};
        const f32x4 ucur = {pg8::bf_lo(uc.x), pg8::bf_hi(uc.x), pg8::bf_lo(uc.y), pg8::bf_hi(uc.y)};
        if (sb + 1 < SSM_L / 16) { const bf16* un = up + (size_t)(16 * (sb + 1)) * SSMW;
            uab = *(const u32x4*)(un + 8 * (fq & 1)); if (PASS2) uc = *(const u32x2*)(un + 4 * fq); }
#pragma unroll
        for (int j = 0; j < 8; ++j) { f32x4 d = {0.f, 0.f, 0.f, 0.f}; d = MFMA16(af, bhi[j], d); d = MFMA16(af, blo[j], d); *(LAS f32x4*)(R + (16 * j + fr) * 20 + 4 * fq) = d; }
        LDS_WAIT();
        f32x4 bre[4], bim[4];
#pragma unroll
        for (int q = 0; q < 4; ++q) { bre[q] = *(const LAS f32x4*)(R + p * 20 + 4 * q); bim[q] = *(const LAS f32x4*)(R + (64 + p) * 20 + 4 * q); }
        LDS_WAIT();
#pragma unroll
        for (int q = 0; q < 4; ++q)
#pragma unroll
            for (int x = 0; x < 4; ++x) { const float nsr = ar * sr - ai * si + bre[q][x], nsi = ar * si + ai * sr + bim[q][x]; sr = nsr; si = nsi;
                if (PASS2) { R[(4 * q + x) * 132 + p] = sr; R[(4 * q + x) * 132 + 64 + p] = si; } }
        if (PASS2) {
            LDS_WAIT();
            f32x4 y = {0.f, 0.f, 0.f, 0.f};
#pragma unroll
            for (int kk = 0; kk < 4; ++kk) { const f32x4 a = *(const LAS f32x4*)(R + fr * 132 + 32 * kk + 8 * fq), b = *(const LAS f32x4*)(R + fr * 132 + 32 * kk + 8 * fq + 4);
                bf16x8 shi, slo; split_bf16(a, b, shi, slo);
                y = MFMA16(chi[kk], shi, y); y = MFMA16(chi[kk], slo, y); y = MFMA16(clo[kk], shi, y); }
            y = y + dv * ucur;
            f32x4 o;
#pragma unroll
            for (int j = 0; j < 4; ++j) { const float v = y[j], z = 0.7978845608028654f * (v + 0.044715f * v * v * v); o[j] = v * __builtin_amdgcn_rcpf(1.0f + __builtin_amdgcn_exp2f(-2.0f * LOG2E * z)); }
            *(unsigned*)((unsigned char*)P.YG + (size_t)(SSM_L * sc + 16 * sb + fr) * SSMW + 16 * g + 4 * fq) = pg8::pk4_fp8(o[0], o[1], o[2], o[3]);
            LDS_WAIT();
        }
    }
    if (!PASS2) ((f32x2*)P.F)[(size_t)(sc * NGRP + g) * NST + p] = (f32x2){sr, si};
    LDS_WAIT();
}

struct Args { const void* in[23]; float* out; unsigned char* ws; };
__global__ void __launch_bounds__(NTHR, 2) mk_fwd(Args args) {
    extern __shared__ __attribute__((aligned(16))) unsigned char lds_raw[];
    LAS unsigned char* lds = (LAS unsigned char*)lds_raw;
    volatile LAS unsigned* MISC = (volatile LAS unsigned*)(lds + MISC_OFF);
    const int G = gridDim.x, bx = blockIdx.x;
#define FRESH_IDS() int lane = xb_lane_id(); asm volatile("" : "+v"(lane)); const int wave = bar.wave, tid = wave * 64 + lane; (void)tid
#define MAKE_PTRS() \
    const __attribute__((address_space(4))) Args* ap_ = (const __attribute__((address_space(4))) Args*)__builtin_amdgcn_kernarg_segment_ptr(); asm volatile("" : "+s"(ap_)); \
    unsigned char* ws = ap_->ws; Ptrs P; \
    P.x = (const float*)ap_->in[0]; P.c = (const float*)ap_->in[1]; P.pos = (const int*)ap_->in[2]; P.w_ada = (const float*)ap_->in[3]; P.b_ada = (const float*)ap_->in[4]; \
    P.n1g = (const float*)ap_->in[5]; P.n2g = (const float*)ap_->in[6]; P.w_in = (const float*)ap_->in[7]; P.qng = (const float*)ap_->in[8]; P.kng = (const float*)ap_->in[9]; \
    P.sinks = (const float*)ap_->in[10]; P.lam_re = (const float*)ap_->in[11]; P.lam_im = (const float*)ap_->in[12]; P.log_dt = (const float*)ap_->in[13]; \
    P.b_re = (const float*)ap_->in[14]; P.b_im = (const float*)ap_->in[15]; P.c_re = (const float*)ap_->in[16]; P.c_im = (const float*)ap_->in[17]; P.dsk = (const float*)ap_->in[18]; \
    P.w_glu = (const float*)ap_->in[19]; P.w_out = (const float*)ap_->in[20]; P.w_ff1 = (const float*)ap_->in[21]; P.w_ff2 = (const float*)ap_->in[22]; \
    P.out = ap_->out; \
    P.MODP = (float*)(ws + WS_MODP); P.MOD = (float*)(ws + WS_MOD); P.ROPE = (float*)(ws + WS_ROPE); P.F = (float*)(ws + WS_F); P.U = (bf16*)(ws + WS_U); P.BIAS2 = (float*)(ws + WS_BIAS2); P.SSQ = (float*)(ws + WS_SSQ); \
    P.H8 = ws + WS_H8; P.WG8 = ws + WS_WG8; P.WINU = (bf16*)(ws + WS_WINU); P.HI8 = ws + WS_HI8; P.MRGI8 = ws + WS_MRGI8; P.MMAX = (float*)(ws + WS_MMAX); P.SAH = (float*)(ws + WS_SAH); P.SAM = (float*)(ws + WS_SAM); P.WMAXU = (unsigned*)(ws + WS_WMAXU); P.WMAXO = (unsigned*)(ws + WS_WMAXO); P.WIN = (bf16*)(ws + WS_WIN); P.WGLU = (bf16*)(ws + WS_WGLU); P.WOUT = (bf16*)(ws + WS_WOUT); P.WFF1 = (bf16*)(ws + WS_WFF1); P.WFF2 = (bf16*)(ws + WS_WFF2); \
    P.H = (bf16*)(ws + WS_H); P.Q = (bf16*)(ws + WS_Q); P.K = (bf16*)(ws + WS_K); P.V = (bf16*)(ws + WS_V); P.GA = (unsigned char*)(ws + WS_GA); P.GS = (unsigned char*)(ws + WS_GS); \
    P.ATT = (bf16*)(ws + WS_ATT); P.YG = (bf16*)(ws + WS_YG); P.MRG = ws + WS_MRG; P.FFH = (bf16*)(ws + WS_FFH); (void)ws

    for (int u = threadIdx.x; u < (LDS_BYTES - MISC_OFF) / 4; u += NTHR) MISC[u] = 0u;
    __syncthreads();
    XcdBarrier bar; { gu32* ctl = (gu32*)(args.ws + WS_CTL); bar = xcd_barrier_post((unsigned*)(ctl + CW_BAR), MISC + 8); }

    { MAKE_PTRS(); FRESH_IDS(); phase0(P, lds, bx, G, tid, wave, lane); }
    xcd_barrier(bar);
    { MAKE_PTRS(); FRESH_IDS(); phase1(P, lds, bx, G, tid, wave, lane); }
    xcd_barrier(bar);
    {
        MAKE_PTRS();
        pg8::Gemm g{(const bf16*)P.H8, (const bf16*)P.WG8, SEQ, 14336, DM / 2}; pg8::StaticOrder S; S.init(SEQ, 14336, G, bx);
        pg8::EpiProj E{P.Q, P.K, P.V, P.GA, P.GS, P.qng, P.kng, P.ROPE, (PG8_LAS float*)(lds + XCH_OFF)};
        pg8::gemm_phase<pg8::EpiProj, pg8::StaticOrder, true, true, true>(lds, g, S, E, bar.wave);
    }
    {
        MAKE_PTRS();
        pg8::Gemm g{(const bf16*)P.HI8, P.WINU, SEQ, 2048, DM / 2}; pg8::StaticOrder S; S.init(SEQ, 2048, G, bx);
        pg8::EpiU E{P.U, P.SAH, P.WMAXU};
        pg8::gemm_phase<pg8::EpiU, pg8::StaticOrder, true, true, false, true>(lds, g, S, E, bar.wave);
    }
    xcd_barrier(bar);
    constexpr int TI_P3 = 18432;
    {
        MAKE_PTRS(); FRESH_IDS();
        for (int u = bx; u < 64 * NKVH; u += G) attn_unit(P, u >> 3, u & 7, lds, tid, wave, lane);
        if (wave < 4) { const int gw4 = bx * 4 + wave, NGW4 = G * 4;
            for (int id = gw4; id < SSM_NSC * NGRP; id += NGW4) ssm_unit<false>(P, id >> 7, id & 127, lds + wave * SSM_WL, lane); }
        const int per = (TI_P3 + G - 1) / G, lo = bx * per, hi = (lo + per < TI_P3) ? lo + per : TI_P3;
        transpose_pool<1>(P, lo, hi, (LAS unsigned*)(lds + MISC_OFF) + 16, (LAS float*)(lds + wave * SSM_WL), lane);
    }
    xcd_barrier(bar);
    {
        MAKE_PTRS(); FRESH_IDS();
        if (wave < 4) { const int gw4 = bx * 4 + wave, NGW4 = G * 4;
            for (int id = gw4; id < SSM_NSC * NGRP; id += NGW4) ssm_unit<true>(P, id >> 7, id & 127, lds + wave * SSM_WL, lane); }
        const int per = (TI_ALL - TI_P3 + G - 1) / G, lo = TI_P3 + bx * per, hi = (lo + per < TI_ALL) ? lo + per : TI_ALL;
        transpose_pool<1>(P, lo, hi, (LAS unsigned*)(lds + MISC_OFF) + 17, (LAS float*)(lds + wave * SSM_WL), lane);
    }
    xcd_barrier(bar);
    {
        MAKE_PTRS();
        pg8::Gemm g{P.YG, P.WGLU, SEQ, 2 * DM, SSMW / 2}; pg8::StaticOrder S; S.init(SEQ, 2 * DM, G, bx);
        pg8::EpiGlu E{P.GS, P.ATT, P.MRG, P.MMAX};
        pg8::gemm_phase<pg8::EpiGlu, pg8::StaticOrder, true, true, true>(lds, g, S, E, bar.wave);
    }
    xcd_barrier(bar);
    {
        MAKE_PTRS(); FRESH_IDS();
        const int gw = bx * NWAVES + wave, NGW = G * NWAVES;
        for (int row = gw; row < SEQ; row += NGW) quant_row(P.MRG + (size_t)row * DM, P.MMAX + (size_t)row * 128, P.MRGI8 + (size_t)row * DM, P.SAM + row, lane);
    }
    xcd_barrier(bar);
    {
        MAKE_PTRS();
        pg8::Gemm g{(const bf16*)P.MRGI8, P.WOUT, SEQ, DM, DM / 2}; pg8::StaticOrder S; S.init(SEQ, DM, G, bx);
        pg8::EpiResid<true> E{P.x, nullptr, nullptr, P.MOD + 2 * DM, P.H, P.SSQ, P.SAM, P.WMAXO};
        pg8::gemm_phase<pg8::EpiResid<true>, pg8::StaticOrder, true, true, false, true>(lds, g, S, E, bar.wave);
    }
    xcd_barrier(bar);
    {
        MAKE_PTRS();
        pg8::Gemm g{P.H, P.WFF1, SEQ, DFF, DM}; pg8::StaticOrder S; S.init(SEQ, DFF, G, bx);
        LAS float* rst = (LAS float*)(lds + XCH_OFF);
        { pg8::Unit u0, ui; S.next(0, u0); bool same = true; for (int i = 1; S.next(i, ui); ++i) same = same && (ui.pm == u0.pm);
          FRESH_IDS(); const int t = tid;
          if (t < 256) { const f32x4* sp = (const f32x4*)(P.SSQ + (size_t)(u0.pm * 256 + t) * 64); f32x4 a = {0.f, 0.f, 0.f, 0.f};
#pragma unroll
              for (int q = 0; q < 16; ++q) a += sp[q];
              const float s = (a[0] + a[1]) + (a[2] + a[3]);
              rst[t] = same ? 1.0f / sqrtf(s * (1.0f / DM) + EPS) : __builtin_nanf(""); }
          __syncthreads(); }
        pg8::EpiRelu2<true> E{P.FFH, DFF, rst, P.BIAS2};
        pg8::gemm_phase<pg8::EpiRelu2<true>, pg8::StaticOrder, true, true>(lds, g, S, E, bar.wave);
    }
    xcd_barrier(bar);
    {
        MAKE_PTRS();
        pg8::Gemm g{P.FFH, P.WFF2, SEQ, DM, DFF}; pg8::StaticOrder S; S.init(SEQ, DM, G, bx);
        pg8::EpiResid<false> E{nullptr, P.H, P.out, P.MOD + 5 * DM, nullptr, nullptr, nullptr, nullptr};
        pg8::gemm_phase<pg8::EpiResid<false>, pg8::StaticOrder, true, true>(lds, g, S, E, bar.wave);
    }
}

extern "C" void kernel_launch(void* const* d_in, const int* in_sizes, int n_in, void* d_out, int out_size, void* d_ws, size_t ws_size, hipStream_t stream) {
    static int grid = 0;
    if (grid == 0) {
        if (n_in != 23 || in_sizes[0] != SEQ * DM || out_size != SEQ * DM || ws_size < WS_END) {
            fprintf(stderr, "kernel_launch: unexpected problem (n_in %d, in0 %d, out %d, ws %zu); nothing launched\n", n_in, n_in > 0 ? in_sizes[0] : -1, out_size, ws_size); grid = -1; return; }
        int dev = 0, cus = 0, per_cu = 0;
        if (hipGetDevice(&dev) != hipSuccess || hipDeviceGetAttribute(&cus, hipDeviceAttributeMultiprocessorCount, dev) != hipSuccess) { fprintf(stderr, "kernel_launch: device query failed\n"); grid = -1; return; }
        if (hipFuncSetAttribute((const void*)mk_fwd, hipFuncAttributeMaxDynamicSharedMemorySize, LDS_BYTES) != hipSuccess) { fprintf(stderr, "kernel_launch: hipFuncSetAttribute failed\n"); grid = -1; return; }
        if (hipOccupancyMaxActiveBlocksPerMultiprocessor(&per_cu, (const void*)mk_fwd, NTHR, LDS_BYTES) != hipSuccess || per_cu < 1)
            fprintf(stderr, "kernel_launch: note: occupancy query reports %d workgroups per CU\n", per_cu);
        (void)hipGetLastError();
        if (cus != 256) { fprintf(stderr, "kernel_launch: built for a 256-CU device (got %d CUs); nothing launched\n", cus); grid = -1; return; }
        grid = cus;
    }
    if (grid < 0) return;
    if (hipMemsetAsync((char*)d_ws + WS_CTL, 0, CTL_ZERO_BYTES, stream) != hipSuccess) { fprintf(stderr, "kernel_launch: memset failed\n"); return; }
    Args a{};
    for (int i = 0; i < 23; ++i) a.in[i] = d_in[i];
    a.out = (float*)d_out; a.ws = (unsigned char*)d_ws;
    hipLaunchKernelGGL(mk_fwd, dim3(grid), dim3(NTHR), LDS_BYTES, stream, a);
    const hipError_t le = hipPeekAtLastError();
    if (le != hipSuccess) fprintf(stderr, "kernel_launch: launch failed: %s\n", hipGetErrorName(le));
}
```

```cpp
#include <hip/hip_runtime.h>
#include <cstdio>
#include <cstdint>
namespace pg8 {
#define PG8_LAS __attribute__((address_space(3)))
typedef unsigned short bf16_t;
typedef short bf16x8 __attribute__((ext_vector_type(8)));
typedef float f32x4 __attribute__((ext_vector_type(4)));
typedef unsigned u32x4 __attribute__((ext_vector_type(4)));
typedef unsigned u32x2 __attribute__((ext_vector_type(2)));
typedef int i32x4 __attribute__((ext_vector_type(4)));
typedef int i32x8 __attribute__((ext_vector_type(8)));
constexpr int BM = 256, BK = 64, HALF = 128, HTB = HALF * BK * 2  , STAGE_BYTES = 8 * HTB, NXCD = 8, WGM = 8;

__host__ __device__ __forceinline__ int lds_byte(int r, int c) { const int st = (r >> 4) * 2 + (c >> 5), rr = r & 15, cc = c & 31, ob = rr * 64 + cc * 2; return st * 1024 + (ob ^ (((ob >> 9) & 1) << 5)); }
__host__ __device__ __forceinline__ void stage_rc(int b, int& R, int& C) { const int st = b / 1024, sb = b % 1024, swz = sb ^ (((sb >> 9) & 1) << 5); R = (st >> 1) * 16 + swz / 64; C = (st & 1) * 32 + (swz % 64) / 2; }
__host__ __device__ __forceinline__ int f8swz(int r) { return ((r >> 1) & 1) | (((r >> 3) & 1) << 2); }
__host__ __device__ __forceinline__ int lds_byte8(int r, int c) { return (r >> 4) * 2048 + (r & 15) * 128 + ((c ^ f8swz(r & 15)) << 4); }
__host__ __device__ __forceinline__ void stage_rc8(int b, int& R, int& Cb) { const int grp = b >> 11, r = (b >> 7) & 15, slot = (b >> 4) & 7; R = grp * 16 + r; Cb = (slot ^ f8swz(r)) << 4; }
__host__ __device__ __forceinline__ int perm32(int rho) { const int n = rho >> 4, i = rho & 15; return 8 * (i >> 2) + 4 * n + (i & 3); }

struct Unit { int pm, pn; };
struct Gemm { const bf16_t* A; const bf16_t* Bt; int M, N, K; };

struct StaticOrder {
    int nM, nN, nwg, G, c;
    __host__ __device__ __forceinline__ void init(int M, int N, int G_, int c_) { nM = M / BM; nN = N / BM; nwg = nM * nN; G = G_; c = c_; }
    __host__ __device__ __forceinline__ bool next(int i, Unit& u) const {
        const long L = (long)i * G + c; if (L >= nwg) return false;
        int wgid = (int)L; { const int q = nwg / NXCD, r = nwg % NXCD, xcd = wgid % NXCD, off = wgid / NXCD; wgid = (xcd < r ? xcd * (q + 1) : r * (q + 1) + (xcd - r) * q) + off; }
        const int nig = WGM * nN, gid = wgid / nig, fm = gid * WGM, gsz = (nM - fm) < WGM ? (nM - fm) : WGM;
        u.pm = fm + ((wgid % nig) % gsz); u.pn = (wgid % nig) / gsz; return true;
    }
    __device__ __forceinline__ void a_ready(const Unit&) const {}
    __device__ __forceinline__ void done(const Unit&) const {}
};


typedef float f32x2 __attribute__((ext_vector_type(2)));
typedef __bf16 bf16x2_t __attribute__((ext_vector_type(2)));
__device__ __forceinline__ unsigned cvt_pk_bf16(float lo, float hi) { f32x2 v = {lo, hi}; bf16x2_t b = __builtin_convertvector(v, bf16x2_t); return __builtin_bit_cast(unsigned, b); }
__device__ __forceinline__ float bf_lo(unsigned w) { return __uint_as_float(w << 16); }
__device__ __forceinline__ float bf_hi(unsigned w) { return __uint_as_float(w & 0xffff0000u); }
__device__ __forceinline__ unsigned pk4_i8(float a, float b, float c, float d) {
    const int ia = (int)__builtin_rintf(fminf(fmaxf(a, -127.f), 127.f)), ib = (int)__builtin_rintf(fminf(fmaxf(b, -127.f), 127.f)), ic = (int)__builtin_rintf(fminf(fmaxf(c, -127.f), 127.f)), id = (int)__builtin_rintf(fminf(fmaxf(d, -127.f), 127.f));
    return (unsigned)(ia & 255) | ((unsigned)(ib & 255) << 8) | ((unsigned)(ic & 255) << 16) | ((unsigned)(id & 255) << 24);
}
__device__ __forceinline__ unsigned pk4_u8(float a, float b, float c, float d) {
    const unsigned ua = (unsigned)(a * 255.0f + 0.5f), ub = (unsigned)(b * 255.0f + 0.5f), uc = (unsigned)(c * 255.0f + 0.5f), ud = (unsigned)(d * 255.0f + 0.5f);
    return ua | (ub << 8) | (uc << 16) | (ud << 24); }
__device__ __forceinline__ float u8f(unsigned w, int i) { return (float)((w >> (8 * i)) & 0xffu); }
__device__ __forceinline__ float sigmoidf_fast(float x) { return __builtin_amdgcn_rcpf(1.0f + __builtin_amdgcn_exp2f(-1.4426950408889634f * x)); }

__device__ __forceinline__ unsigned pk4_fp8(float a, float b, float c, float d) {
    a = fminf(fmaxf(a, -448.f), 448.f); b = fminf(fmaxf(b, -448.f), 448.f); c = fminf(fmaxf(c, -448.f), 448.f); d = fminf(fmaxf(d, -448.f), 448.f);
    int w = 0; w = __builtin_amdgcn_cvt_pk_fp8_f32(a, b, w, false); w = __builtin_amdgcn_cvt_pk_fp8_f32(c, d, w, true); return (unsigned)w;
}
constexpr float W8_SCALE = 128.0f;
constexpr float QSCALE = 0.08838834764831845f * 1.4426950408889634f;

struct EpiProj {
    static constexpr bool PERM = false, AFTER_DRAIN = false;
    bf16_t *Q, *K, *V; unsigned char *GA, *GS;     const float *qg, *kg, *rope; PG8_LAS float* xch;
    __device__ __forceinline__ void operator()(f32x4 (&acc)[2][2][4][2], const Unit& u, int wr, int wc, int fr, int fq) const {
        constexpr float DS = 1.0f / W8_SCALE;
        const int row0 = u.pm * BM + wr * 64 + fr; const int pn = u.pn;
        if (pn < 20) {
            const bool isq = pn < 16; const int head0 = isq ? 2 * pn : 2 * (pn - 16); bf16_t* dst = isq ? Q : K; const int ld = isq ? 4096 : 1024;
            const float* gain = isq ? qg : kg; const float osc = isq ? QSCALE : 1.0f;
#pragma unroll
            for (int ai = 0; ai < 2; ++ai)
#pragma unroll
                for (int m = 0; m < 4; ++m)
#pragma unroll
                    for (int bj = 0; bj < 2; ++bj) {
                        const f32x4 a0 = acc[ai][bj][m][0] * DS, a1 = acc[ai][bj][m][1] * DS;
                        float ss = (a0[0] * a0[0] + a0[1] * a0[1]) + (a0[2] * a0[2] + a0[3] * a0[3]) + (a1[0] * a1[0] + a1[1] * a1[1]) + (a1[2] * a1[2] + a1[3] * a1[3]);
                        ss += __shfl_xor(ss, 16); ss += __shfl_xor(ss, 32);
                        if (fq == 0) xch[((ai * HALF + wr * 64 + m * 16 + fr) * 2 + bj) * 4 + wc] = ss;
                    }
            asm volatile("s_waitcnt lgkmcnt(0)" ::: "memory"); __builtin_amdgcn_s_barrier(); asm volatile("" ::: "memory");
            f32x4 gv[2];
#pragma unroll
            for (int n = 0; n < 2; ++n) gv[n] = *(const f32x4*)(gain + 32 * wc + 16 * n + 4 * fq);
#pragma unroll
            for (int ai = 0; ai < 2; ++ai) {
                f32x4 csv[4], snv[4];
                if (wc == 0) {
#pragma unroll
                    for (int m = 0; m < 4; ++m) { const size_t row = (size_t)(u.pm * BM + ai * HALF + wr * 64 + m * 16 + fr);
                        csv[m] = *(const f32x4*)(rope + row * 32 + 4 * fq); snv[m] = *(const f32x4*)(rope + row * 32 + 16 + 4 * fq); }
                }
#pragma unroll
                for (int m = 0; m < 4; ++m) {
                    const int rl = ai * HALF + wr * 64 + m * 16 + fr; const size_t row = (size_t)(u.pm * BM + rl);
                    f32x4 cs = {1.f, 1.f, 1.f, 1.f}, sn = {0.f, 0.f, 0.f, 0.f};
                    if (wc == 0) { cs = csv[m]; sn = snv[m]; }
#pragma unroll
                    for (int bj = 0; bj < 2; ++bj) {
                        const f32x4 t = *(const PG8_LAS f32x4*)(xch + (rl * 2 + bj) * 4);
                        const float tot = (t[0] + t[1]) + (t[2] + t[3]);
                        const float rstd = 1.0f / sqrtf(tot * (1.0f / 128.0f) + 1e-6f);
                        f32x4 y0 = acc[ai][bj][m][0] * (DS * rstd) * gv[0], y1 = acc[ai][bj][m][1] * (DS * rstd) * gv[1];
                        if (wc == 0) { const f32x4 r0 = y0 * cs - y1 * sn, r1 = y1 * cs + y0 * sn; y0 = r0; y1 = r1; }
                        y0 = y0 * osc; y1 = y1 * osc;
                        u32x4 w; w.x = cvt_pk_bf16(y0[0], y0[1]); w.y = cvt_pk_bf16(y0[2], y0[3]); w.z = cvt_pk_bf16(y1[0], y1[1]); w.w = cvt_pk_bf16(y1[2], y1[3]);
                        *(u32x4*)(dst + row * ld + (head0 + bj) * 128 + 32 * wc + 8 * fq) = w;
                    }
                }
                asm volatile("" ::: "memory");
            }
        } else if (pn < 24) {
            const int col0 = (pn - 20) * BM + wc * 32 + 8 * fq;
#pragma unroll
            for (int ai = 0; ai < 2; ++ai)
#pragma unroll
                for (int m = 0; m < 4; ++m) { bf16_t* rowp = V + (size_t)(row0 + ai * HALF + m * 16) * 1024 + col0;
#pragma unroll
                    for (int bj = 0; bj < 2; ++bj) { const f32x4 v0 = acc[ai][bj][m][0] * DS, v1 = acc[ai][bj][m][1] * DS;
                        u32x4 w; w.x = cvt_pk_bf16(v0[0], v0[1]); w.y = cvt_pk_bf16(v0[2], v0[3]); w.z = cvt_pk_bf16(v1[0], v1[1]); w.w = cvt_pk_bf16(v1[2], v1[3]);
                        *(u32x4*)(rowp + bj * HALF) = w; } }
        } else {
            unsigned char* dst = pn < 40 ? GA : GS; const int col0 = ((pn - 24) & 15) * BM + wc * 32 + 8 * fq;
#pragma unroll
            for (int ai = 0; ai < 2; ++ai)
#pragma unroll
                for (int m = 0; m < 4; ++m) { unsigned char* rowp = dst + (size_t)(row0 + ai * HALF + m * 16) * 4096 + col0;
#pragma unroll
                    for (int bj = 0; bj < 2; ++bj) { f32x4 v0 = acc[ai][bj][m][0] * DS, v1 = acc[ai][bj][m][1] * DS;
#pragma unroll
                        for (int j = 0; j < 4; ++j) { v0[j] = sigmoidf_fast(v0[j]); v1[j] = sigmoidf_fast(v1[j]); }
                        u32x2 w; w.x = pk4_u8(v0[0], v0[1], v0[2], v0[3]); w.y = pk4_u8(v1[0], v1[1], v1[2], v1[3]);
                        *(u32x2*)(rowp + bj * HALF) = w; } }
        }
    }
};

__device__ __forceinline__ f32x4 i32_to_f32(const f32x4 a) { const i32x4 v = __builtin_bit_cast(i32x4, a); return (f32x4){(float)v[0], (float)v[1], (float)v[2], (float)v[3]}; }
struct EpiU {
    static constexpr bool PERM = false, AFTER_DRAIN = false;
    bf16_t* U; const float* sa; const unsigned* wmax;
    __device__ __forceinline__ void operator()(const f32x4 (&acc)[2][2][4][2], const Unit& u, int wr, int wc, int fr, int fq) const {
        const int row0 = u.pm * BM + wr * 64 + fr, col0 = u.pn * BM + wc * 32 + 8 * fq;
        f32x4 sw[2][2];
#pragma unroll
        for (int bj = 0; bj < 2; ++bj)
#pragma unroll
            for (int n = 0; n < 2; ++n) { const u32x4 w = *(const u32x4*)(wmax + col0 + bj * HALF + 4 * n);
                sw[bj][n] = (f32x4){__uint_as_float(w.x), __uint_as_float(w.y), __uint_as_float(w.z), __uint_as_float(w.w)} * (1.0f / 127.0f); }
#pragma unroll
        for (int ai = 0; ai < 2; ++ai)
#pragma unroll
            for (int m = 0; m < 4; ++m) { const int row = row0 + ai * HALF + m * 16; bf16_t* rowp = U + (size_t)row * 2048 + col0; const float s = sa[row];
#pragma unroll
                for (int bj = 0; bj < 2; ++bj) { const f32x4 v0 = i32_to_f32(acc[ai][bj][m][0]) * (sw[bj][0] * s), v1 = i32_to_f32(acc[ai][bj][m][1]) * (sw[bj][1] * s);
                    u32x4 w; w.x = cvt_pk_bf16(v0[0], v0[1]); w.y = cvt_pk_bf16(v0[2], v0[3]); w.z = cvt_pk_bf16(v1[0], v1[1]); w.w = cvt_pk_bf16(v1[2], v1[3]);
                    *(u32x4*)(rowp + bj * HALF) = w; } }
    }
};

struct EpiGlu {
    static constexpr bool PERM = false, AFTER_DRAIN = false;
    const unsigned char* GS; const bf16_t* ATT; unsigned char* MRG; float* mmax;
    __device__ __forceinline__ void operator()(const f32x4 (&acc)[2][2][4][2], const Unit& u, int wr, int wc, int fr, int fq) const {
        const int row0 = u.pm * BM + wr * 64 + fr; const int ch0 = u.pn * 128 + wc * 32 + 8 * fq;
        constexpr float DS = 1.0f / W8_SCALE;
        u32x2 gs[2][4]; u32x4 at[2][4];
#pragma unroll
        for (int ai = 0; ai < 2; ++ai)
#pragma unroll
            for (int m = 0; m < 4; ++m) { const size_t off = (size_t)(row0 + ai * HALF + m * 16) * 4096 + ch0; gs[ai][m] = *(const u32x2*)(GS + off); at[ai][m] = *(const u32x4*)(ATT + off); }
#pragma unroll
        for (int ai = 0; ai < 2; ++ai) {
#pragma unroll
            for (int m = 0; m < 4; ++m) {
                const size_t off = (size_t)(row0 + ai * HALF + m * 16) * 4096 + ch0;
                float mv[8]; float am = 0.f;
#pragma unroll
                for (int q = 0; q < 4; ++q) {
                    const int n = q >> 1, j = 2 * (q & 1);
                    const float v0 = acc[ai][0][m][n][j] * DS, v1 = acc[ai][0][m][n][j + 1] * DS, g0 = acc[ai][1][m][n][j] * DS, g1 = acc[ai][1][m][n][j + 1] * DS;
                    const float s0 = v0 * sigmoidf_fast(g0), s1 = v1 * sigmoidf_fast(g1);
                    const float m0 = bf_lo(at[ai][m][q]) + u8f(gs[ai][m][n], j) * (s0 * (1.0f / 255.0f)), m1 = bf_hi(at[ai][m][q]) + u8f(gs[ai][m][n], j + 1) * (s1 * (1.0f / 255.0f));
                    am = fmaxf(am, fmaxf(fabsf(m0), fabsf(m1)));
                    mv[2 * q] = m0; mv[2 * q + 1] = m1;
                }
                am = fmaxf(am, __shfl_xor(am, 16)); am = fmaxf(am, __shfl_xor(am, 32));
                const float iq = am > 0.f ? 127.0f * __builtin_amdgcn_rcpf(am) : 0.f;
                u32x2 w; w.x = pk4_i8(mv[0] * iq, mv[1] * iq, mv[2] * iq, mv[3] * iq); w.y = pk4_i8(mv[4] * iq, mv[5] * iq, mv[6] * iq, mv[7] * iq);
                *(u32x2*)(MRG + off) = w;
                if (fq == 0) mmax[(size_t)(row0 + ai * HALF + m * 16) * 128 + 4 * u.pn + wc] = am;
            }
        }
    }
};

template <bool NORM> struct EpiResid {
    static constexpr bool PERM = false, AFTER_DRAIN = false;
    const float* xin; const bf16_t* x1b_in; float* out; const float* gate; bf16_t* x1b_out; float* ssq; const float* sa; const unsigned* wmax;
    __device__ __forceinline__ void operator()(const f32x4 (&acc)[2][2][4][2], const Unit& u, int wr, int wc, int fr, int fq) const {
        const int row0 = u.pm * BM + wr * 64 + fr, col0 = u.pn * BM + wc * 32 + 8 * fq;
        f32x4 gv[2][2];
#pragma unroll
        for (int bj = 0; bj < 2; ++bj)
#pragma unroll
            for (int n = 0; n < 2; ++n) gv[bj][n] = *(const f32x4*)(gate + col0 + bj * HALF + 4 * n);
        if constexpr (NORM) {
#pragma unroll
            for (int bj = 0; bj < 2; ++bj)
#pragma unroll
                for (int n = 0; n < 2; ++n) { const u32x4 w = *(const u32x4*)(wmax + col0 + bj * HALF + 4 * n);
                    gv[bj][n] = gv[bj][n] * (f32x4){__uint_as_float(w.x), __uint_as_float(w.y), __uint_as_float(w.z), __uint_as_float(w.w)} * (1.0f / 127.0f); }
#pragma unroll
            for (int ai = 0; ai < 2; ++ai) {
                f32x4 bs[4][2][2];
#pragma unroll
                for (int m = 0; m < 4; ++m) { const size_t off = (size_t)(row0 + ai * HALF + m * 16) * 4096 + col0;
#pragma unroll
                    for (int bj = 0; bj < 2; ++bj)
#pragma unroll
                        for (int n = 0; n < 2; ++n) bs[m][bj][n] = *(const f32x4*)(xin + off + bj * HALF + 4 * n); }
#pragma unroll
                for (int m = 0; m < 4; ++m) { const int row = row0 + ai * HALF + m * 16; const size_t off = (size_t)row * 4096 + col0; float ss = 0.f; const float rs = sa[row];
#pragma unroll
                    for (int bj = 0; bj < 2; ++bj) { const f32x4 o0 = bs[m][bj][0] + gv[bj][0] * (i32_to_f32(acc[ai][bj][m][0]) * rs), o1 = bs[m][bj][1] + gv[bj][1] * (i32_to_f32(acc[ai][bj][m][1]) * rs);
                        ss += (o0[0] * o0[0] + o0[1] * o0[1]) + (o0[2] * o0[2] + o0[3] * o0[3]) + (o1[0] * o1[0] + o1[1] * o1[1]) + (o1[2] * o1[2] + o1[3] * o1[3]);
                        u32x4 w; w.x = cvt_pk_bf16(o0[0], o0[1]); w.y = cvt_pk_bf16(o0[2], o0[3]); w.z = cvt_pk_bf16(o1[0], o1[1]); w.w = cvt_pk_bf16(o1[2], o1[3]);
                        *(u32x4*)(x1b_out + off + bj * HALF) = w; }
                    ss += __shfl_xor(ss, 16); ss += __shfl_xor(ss, 32); if (fq == 0) ssq[(size_t)row * 64 + 4 * u.pn + wc] = ss; }
                asm volatile("" ::: "memory");
            }
        } else {
#pragma unroll
            for (int ai = 0; ai < 2; ++ai) {
                u32x4 bs[4][2];
#pragma unroll
                for (int m = 0; m < 4; ++m) { const size_t off = (size_t)(row0 + ai * HALF + m * 16) * 4096 + col0;
#pragma unroll
                    for (int bj = 0; bj < 2; ++bj) bs[m][bj] = *(const u32x4*)(x1b_in + off + bj * HALF); }
#pragma unroll
                for (int m = 0; m < 4; ++m) { const size_t off = (size_t)(row0 + ai * HALF + m * 16) * 4096 + col0;
#pragma unroll
                    for (int bj = 0; bj < 2; ++bj) { const u32x4 b = bs[m][bj];
                        const f32x4 x0 = {bf_lo(b.x), bf_hi(b.x), bf_lo(b.y), bf_hi(b.y)}, x1 = {bf_lo(b.z), bf_hi(b.z), bf_lo(b.w), bf_hi(b.w)};
                        *(f32x4*)(out + off + bj * HALF) = x0 + gv[bj][0] * acc[ai][bj][m][0]; *(f32x4*)(out + off + bj * HALF + 4) = x1 + gv[bj][1] * acc[ai][bj][m][1]; } }
                asm volatile("" ::: "memory");
            }
        }
    }
};

template <bool NORM> struct EpiRelu2 {
    static constexpr bool PERM = false, AFTER_DRAIN = false;
    bf16_t* O; int ldc; const PG8_LAS float* rstd; const float* bias;
    __device__ __forceinline__ void operator()(const f32x4 (&acc)[2][2][4][2], const Unit& u, int wr, int wc, int fr, int fq) const {
        const int row0 = u.pm * BM + wr * 64 + fr, col0 = u.pn * BM + wc * 32 + 8 * fq;
        f32x4 bv[2][2];
#pragma unroll
        for (int bj = 0; bj < 2; ++bj)
#pragma unroll
            for (int n = 0; n < 2; ++n) bv[bj][n] = NORM ? *(const f32x4*)(bias + col0 + bj * HALF + 4 * n) : (f32x4){0.f, 0.f, 0.f, 0.f};
#pragma unroll
        for (int ai = 0; ai < 2; ++ai)
#pragma unroll
            for (int m = 0; m < 4; ++m) { bf16_t* rowp = O + (size_t)(row0 + ai * HALF + m * 16) * ldc + col0;
                const float rs = NORM ? rstd[ai * HALF + wr * 64 + m * 16 + fr] : 1.0f;
#pragma unroll
                for (int bj = 0; bj < 2; ++bj) { f32x4 v0 = acc[ai][bj][m][0], v1 = acc[ai][bj][m][1];
                    if (NORM) { v0 = v0 * rs + bv[bj][0]; v1 = v1 * rs + bv[bj][1]; }
#pragma unroll
                    for (int j = 0; j < 4; ++j) { const float a = fmaxf(v0[j], 0.f), b = fmaxf(v1[j], 0.f); v0[j] = a * a; v1[j] = b * b; }
                    u32x4 w; w.x = cvt_pk_bf16(v0[0], v0[1]); w.y = cvt_pk_bf16(v0[2], v0[3]); w.z = cvt_pk_bf16(v1[0], v1[1]); w.w = cvt_pk_bf16(v1[2], v1[3]);
                    *(u32x4*)(rowp + bj * HALF) = w; } }
    }
};
template <class Epi, class Sched, bool ALIGN_EPI = false, bool SP2 = false, bool FP8 = false, bool I8 = false, bool SP4 = false>
__device__ __forceinline__ void gemm_phase(PG8_LAS unsigned char* lds, const Gemm g, const Sched& S, const Epi& E, const int wave_id  ) {
    int tid_ = wave_id * 64 + (int)__builtin_amdgcn_mbcnt_hi(~0u, __builtin_amdgcn_mbcnt_lo(~0u, 0u)); asm volatile("" : "+v"(tid_));
    const int tid = tid_, wid = __builtin_amdgcn_readfirstlane(tid >> 6), lane = tid & 63, wr = wid >> 2, wc = wid & 3, fr = lane & 15, fq = lane >> 4;
    const int K = g.K, nt = K / BK;
    unsigned voffA[2], voffB[2];
#pragma unroll
    for (int i = 0; i < 2; ++i) {
        if constexpr (FP8) { int R, Cb; stage_rc8(tid * 16 + i * 8192, R, Cb); voffA[i] = (unsigned)(R * K) * 2u + (unsigned)Cb; voffB[i] = voffA[i]; }
        else { int R, C; stage_rc(tid * 16 + i * 8192, R, C); const int Rb = Epi::PERM ? ((R & ~31) + perm32(R & 31)) : R;
            voffA[i] = (unsigned)(R * K + C) * 2u; voffB[i] = (unsigned)(Rb * K + C) * 2u; } }
    const size_t r64step = (size_t)64 * K * 2;
    const size_t kstep = (size_t)(BK * 2);
    const size_t hstep = (size_t)HALF * K * 2;
    const size_t tstep = 2 * hstep;
    const unsigned ldsw = (unsigned)wid * 1024u;
    const int aoff = lds_byte(wr * 64 + fr, fq * 8), boff = lds_byte(wc * 32 + fr, fq * 8);
    const int aoff8 = lds_byte8(wr * 64 + fr, 2 * fq), aoff8b = lds_byte8(wr * 64 + fr, 2 * fq + 1), boff8 = lds_byte8(wc * 32 + fr, 2 * fq), boff8b = lds_byte8(wc * 32 + fr, 2 * fq + 1);
#define PG8_SA(b, h) (((b) * 2 + (h)) * HTB)
#define PG8_SB(b, h) ((4 + (b) * 2 + (h)) * HTB)
#define PG8_STAGE(bufoff, gbase, voff) do { _Pragma("unroll") for (int _i = 0; _i < 2; ++_i)     \
        __builtin_amdgcn_global_load_lds((const unsigned*)((const char*)(gbase) + (size_t)_i * r64step + (voff)[0]), (PG8_LAS unsigned*)(lds + (bufoff) + ldsw + _i * 8192), 16, 0, 0); } while (0)
#define PG8_LDA(dst, b, h) do { _Pragma("unroll") for (int m = 0; m < 4; ++m) _Pragma("unroll") for (int k = 0; k < 2; ++k) dst[m][k] = *(const PG8_LAS bf16x8*)(lds + PG8_SA(b, h) + aoff + m * 2048 + k * 1024); } while (0)
#define PG8_LDB(dst, b, h) do { _Pragma("unroll") for (int n = 0; n < 2; ++n) _Pragma("unroll") for (int k = 0; k < 2; ++k) dst[n][k] = *(const PG8_LAS bf16x8*)(lds + PG8_SB(b, h) + boff + n * 2048 + k * 1024); } while (0)
#define PG8_MMA(ai, bj, At, Bt) do { __builtin_amdgcn_s_setprio(1); _Pragma("unroll") for (int m = 0; m < 4; ++m) _Pragma("unroll") for (int n = 0; n < 2; ++n) _Pragma("unroll") for (int k = 0; k < 2; ++k) \
        acc[ai][bj][m][n] = __builtin_amdgcn_mfma_f32_16x16x32_bf16(Bt[n][k], At[m][k], acc[ai][bj][m][n], 0, 0, 0); __builtin_amdgcn_s_setprio(0); } while (0)
#define PG8_LDA8(dst, b, h) do { _Pragma("unroll") for (int m = 0; m < 4; ++m) { const PG8_LAS unsigned char* p_ = lds + PG8_SA(b, h) + aoff8 + m * 2048; \
        dst[m] = __builtin_shufflevector(*(const PG8_LAS i32x4*)p_, *(const PG8_LAS i32x4*)(lds + PG8_SA(b, h) + aoff8b + m * 2048), 0, 1, 2, 3, 4, 5, 6, 7); } } while (0)
#define PG8_LDB8(dst, b, h) do { _Pragma("unroll") for (int n = 0; n < 2; ++n) { const PG8_LAS unsigned char* p_ = lds + PG8_SB(b, h) + boff8 + n * 2048; \
        dst[n] = __builtin_shufflevector(*(const PG8_LAS i32x4*)p_, *(const PG8_LAS i32x4*)(lds + PG8_SB(b, h) + boff8b + n * 2048), 0, 1, 2, 3, 4, 5, 6, 7); } } while (0)
#define PG8_MMA8(ai, bj, At, Bt) do { __builtin_amdgcn_s_setprio(1); _Pragma("unroll") for (int m = 0; m < 4; ++m) _Pragma("unroll") for (int n = 0; n < 2; ++n) \
        asm volatile("v_mfma_scale_f32_16x16x128_f8f6f4 %0, %1, %2, %0, %3, %3 op_sel_hi:[0,0,0]" : "+v"(acc[ai][bj][m][n]) : "v"(Bt[n]), "v"(At[m]), "v"(one8)); __builtin_amdgcn_s_setprio(0); } while (0)
#define PG8_MMAI(ai, bj, At, Bt) do { __builtin_amdgcn_s_setprio(1); _Pragma("unroll") for (int m = 0; m < 4; ++m) _Pragma("unroll") for (int n = 0; n < 2; ++n) _Pragma("unroll") for (int k = 0; k < 2; ++k) \
        asm volatile("v_mfma_i32_16x16x64_i8 %0, %1, %2, %0" : "+v"(acc[ai][bj][m][n]) : "v"(Bt[n][k]), "v"(At[m][k])); __builtin_amdgcn_s_setprio(0); } while (0)
#define PG8_WAIT_V(n) asm volatile("s_waitcnt vmcnt(" #n ")" ::: "memory")
#define PG8_WAIT_L(n) asm volatile("s_waitcnt lgkmcnt(" #n ")" ::: "memory")
#define PG8_BAR __builtin_amdgcn_s_barrier()
#define PG8_SCHED __builtin_amdgcn_sched_barrier(0)
    Unit cur, nxt; int ui = 0;
    if (!S.next(0, cur)) return;
    f32x4 acc[2][2][4][2];
#pragma unroll
    for (int a = 0; a < 2; ++a)
#pragma unroll
        for (int b = 0; b < 2; ++b)
#pragma unroll
            for (int m = 0; m < 4; ++m)
#pragma unroll
                for (int n = 0; n < 2; ++n) acc[a][b][m][n] = (f32x4){0.f, 0.f, 0.f, 0.f};
    bf16x8 At[4][2], B0[2][2], B1[2][2];
    bf16x8 At1[4][2];
    int one8 = 0x7F7F7F7F; if constexpr (FP8) asm volatile("" : "+v"(one8));
    i32x8 At8[4], B08[2], B18[2];
    const char* cA = (const char*)g.A + (size_t)cur.pm * tstep; const char* cB = (const char*)g.Bt + (size_t)cur.pn * tstep;
    S.a_ready(cur);
#define PG8_STAGE4(b, pa, pb) do { PG8_STAGE(PG8_SB(b, 0), pb, voffB); PG8_STAGE(PG8_SB(b, 1), (pb) + hstep, voffB); PG8_STAGE(PG8_SA(b, 0), pa, voffA); PG8_STAGE(PG8_SA(b, 1), (pa) + hstep, voffA); } while (0)
#define PG8_MMAX(ai, bj, A_, B_) do { if constexpr (I8) PG8_MMAI(ai, bj, A_, B_); else PG8_MMA(ai, bj, A_, B_); } while (0)
    if constexpr (SP4) {
        PG8_STAGE4(0, cA, cB);
        if (wr == 1) { PG8_STAGE4(1, cA + kstep, cB + kstep); PG8_BAR; PG8_WAIT_V(8); } else { PG8_WAIT_V(0); }
        PG8_BAR; PG8_BAR;
    } else
    if constexpr (SP2) {
        PG8_STAGE(PG8_SB(0, 0), cB, voffB); PG8_STAGE(PG8_SB(0, 1), cB + hstep, voffB); PG8_STAGE(PG8_SA(0, 0), cA, voffA); PG8_STAGE(PG8_SA(0, 1), cA + hstep, voffA);
        if (wr == 1) PG8_BAR;
        PG8_WAIT_V(2); PG8_BAR;
        PG8_STAGE(PG8_SB(1, 0), cB + kstep, voffB); PG8_STAGE(PG8_SA(1, 0), cA + kstep, voffA); PG8_STAGE(PG8_SB(1, 1), cB + hstep + kstep, voffB);
        PG8_WAIT_V(6); PG8_BAR;
    } else {
        PG8_STAGE(PG8_SB(0, 0), cB, voffB); PG8_STAGE(PG8_SA(0, 0), cA, voffA); PG8_STAGE(PG8_SB(0, 1), cB + hstep, voffB); PG8_STAGE(PG8_SA(0, 1), cA + hstep, voffA);
        if (wr == 1) PG8_BAR;
        PG8_WAIT_V(4); PG8_BAR;
        PG8_STAGE(PG8_SB(1, 0), cB + kstep, voffB); PG8_STAGE(PG8_SA(1, 0), cA + kstep, voffA); PG8_STAGE(PG8_SB(1, 1), cB + hstep + kstep, voffB);
        PG8_WAIT_V(6); PG8_BAR;
    }
    for (;;) {
        const bool has_next = S.next(ui + 1, nxt);
        const char* nA = has_next ? (const char*)g.A + (size_t)nxt.pm * tstep : cA; const char* nB = has_next ? (const char*)g.Bt + (size_t)nxt.pn * tstep : cB;
        for (int t = 0; t < nt; t += 2) {
            const bool last = (t == nt - 2);
            const char* a1 = cA + (size_t)(t + 1) * kstep; const char* b1x = cB + (size_t)(t + 1) * kstep;
            const char* a2 = last ? nA : cA + (size_t)(t + 2) * kstep; const char* b2 = last ? nB : cB + (size_t)(t + 2) * kstep;
            const char* a3 = a2 + kstep; const char* b3 = b2 + kstep;
            if (last && has_next) S.a_ready(nxt);
            if constexpr (SP4) {
            PG8_LDB(B0, 0, 0); PG8_LDB(B1, 0, 1); PG8_SCHED; PG8_LDA(At, 0, 0); PG8_LDA(At1, 0, 1);
            if (wr == 0) PG8_STAGE4(1, a1, b1x);
            PG8_WAIT_L(0); if (wr == 1) PG8_WAIT_V(0); PG8_BAR;
            if (wr == 1) PG8_STAGE4(0, a2, b2);
            PG8_MMAX(0, 0, At, B0); PG8_MMAX(0, 1, At, B1); PG8_MMAX(1, 0, At1, B0); PG8_MMAX(1, 1, At1, B1);
            if (wr == 0) PG8_WAIT_V(0); PG8_BAR; PG8_SCHED;
            PG8_LDB(B0, 1, 0); PG8_LDB(B1, 1, 1); PG8_SCHED; PG8_LDA(At, 1, 0); PG8_LDA(At1, 1, 1);
            if (wr == 0) PG8_STAGE4(0, a2, b2);
            PG8_WAIT_L(0); if (wr == 1) PG8_WAIT_V(0); PG8_BAR;
            if (wr == 1) PG8_STAGE4(1, a3, b3);
            PG8_MMAX(0, 0, At, B0); PG8_MMAX(0, 1, At, B1); PG8_MMAX(1, 0, At1, B0); PG8_MMAX(1, 1, At1, B1);
            if (wr == 0) PG8_WAIT_V(0); PG8_BAR; PG8_SCHED;
            } else
            if constexpr (SP2) {
            if constexpr (FP8) {
            PG8_LDB8(B08, 0, 0); PG8_LDB8(B18, 0, 1); PG8_SCHED; PG8_LDA8(At8, 0, 0); PG8_STAGE(PG8_SA(1, 1), a1 + hstep, voffA);
            PG8_WAIT_V(8); PG8_WAIT_L(0); PG8_BAR; PG8_MMA8(0, 0, At8, B08); PG8_MMA8(0, 1, At8, B18); PG8_BAR; PG8_SCHED;
            PG8_LDA8(At8, 0, 1); PG8_STAGE(PG8_SB(0, 0), b2, voffB); PG8_STAGE(PG8_SB(0, 1), b2 + hstep, voffB); PG8_STAGE(PG8_SA(0, 0), a2, voffA);
            PG8_WAIT_V(8); PG8_WAIT_L(0); PG8_BAR; PG8_MMA8(1, 0, At8, B08); PG8_MMA8(1, 1, At8, B18); PG8_BAR; PG8_SCHED;
            PG8_LDB8(B08, 1, 0); PG8_LDB8(B18, 1, 1); PG8_SCHED; PG8_LDA8(At8, 1, 0); PG8_STAGE(PG8_SA(0, 1), a2 + hstep, voffA);
            PG8_WAIT_V(8); PG8_WAIT_L(0); PG8_BAR; PG8_MMA8(0, 0, At8, B08); PG8_MMA8(0, 1, At8, B18); PG8_BAR; PG8_SCHED;
            PG8_LDA8(At8, 1, 1); PG8_STAGE(PG8_SB(1, 0), b3, voffB); PG8_STAGE(PG8_SB(1, 1), b3 + hstep, voffB); PG8_STAGE(PG8_SA(1, 0), a3, voffA);
            PG8_WAIT_V(8); PG8_WAIT_L(0); PG8_BAR; PG8_MMA8(1, 0, At8, B08); PG8_MMA8(1, 1, At8, B18); PG8_BAR; PG8_SCHED;
            } else if constexpr (I8) {
            PG8_LDB(B0, 0, 0); PG8_LDB(B1, 0, 1); PG8_SCHED; PG8_LDA(At, 0, 0); PG8_STAGE(PG8_SA(1, 1), a1 + hstep, voffA);
            PG8_WAIT_V(8); PG8_WAIT_L(0); PG8_BAR; PG8_MMAI(0, 0, At, B0); PG8_MMAI(0, 1, At, B1); PG8_BAR; PG8_SCHED;
            PG8_LDA(At, 0, 1); PG8_STAGE(PG8_SB(0, 0), b2, voffB); PG8_STAGE(PG8_SB(0, 1), b2 + hstep, voffB); PG8_STAGE(PG8_SA(0, 0), a2, voffA);
            PG8_WAIT_V(8); PG8_WAIT_L(0); PG8_BAR; PG8_MMAI(1, 0, At, B0); PG8_MMAI(1, 1, At, B1); PG8_BAR; PG8_SCHED;
            PG8_LDB(B0, 1, 0); PG8_LDB(B1, 1, 1); PG8_SCHED; PG8_LDA(At, 1, 0); PG8_STAGE(PG8_SA(0, 1), a2 + hstep, voffA);
            PG8_WAIT_V(8); PG8_WAIT_L(0); PG8_BAR; PG8_MMAI(0, 0, At, B0); PG8_MMAI(0, 1, At, B1); PG8_BAR; PG8_SCHED;
            PG8_LDA(At, 1, 1); PG8_STAGE(PG8_SB(1, 0), b3, voffB); PG8_STAGE(PG8_SB(1, 1), b3 + hstep, voffB); PG8_STAGE(PG8_SA(1, 0), a3, voffA);
            PG8_WAIT_V(8); PG8_WAIT_L(0); PG8_BAR; PG8_MMAI(1, 0, At, B0); PG8_MMAI(1, 1, At, B1); PG8_BAR; PG8_SCHED;
            } else {
            PG8_LDB(B0, 0, 0); PG8_LDB(B1, 0, 1); PG8_SCHED; PG8_LDA(At, 0, 0); PG8_STAGE(PG8_SA(1, 1), a1 + hstep, voffA);
            PG8_WAIT_V(8); PG8_WAIT_L(0); PG8_BAR; PG8_MMA(0, 0, At, B0); PG8_MMA(0, 1, At, B1); PG8_BAR; PG8_SCHED;
            PG8_LDA(At, 0, 1); PG8_STAGE(PG8_SB(0, 0), b2, voffB); PG8_STAGE(PG8_SB(0, 1), b2 + hstep, voffB); PG8_STAGE(PG8_SA(0, 0), a2, voffA);
            PG8_WAIT_V(8); PG8_WAIT_L(0); PG8_BAR; PG8_MMA(1, 0, At, B0); PG8_MMA(1, 1, At, B1); PG8_BAR; PG8_SCHED;
            PG8_LDB(B0, 1, 0); PG8_LDB(B1, 1, 1); PG8_SCHED; PG8_LDA(At, 1, 0); PG8_STAGE(PG8_SA(0, 1), a2 + hstep, voffA);
            PG8_WAIT_V(8); PG8_WAIT_L(0); PG8_BAR; PG8_MMA(0, 0, At, B0); PG8_MMA(0, 1, At, B1); PG8_BAR; PG8_SCHED;
            PG8_LDA(At, 1, 1); PG8_STAGE(PG8_SB(1, 0), b3, voffB); PG8_STAGE(PG8_SB(1, 1), b3 + hstep, voffB); PG8_STAGE(PG8_SA(1, 0), a3, voffA);
            PG8_WAIT_V(8); PG8_WAIT_L(0); PG8_BAR; PG8_MMA(1, 0, At, B0); PG8_MMA(1, 1, At, B1); PG8_BAR; PG8_SCHED;
            }
            } else {
            PG8_LDB(B0, 0, 0); PG8_SCHED; PG8_LDA(At, 0, 0); PG8_STAGE(PG8_SA(1, 1), a1 + hstep, voffA);
            PG8_WAIT_L(8); PG8_BAR; PG8_WAIT_L(0); PG8_MMA(0, 0, At, B0); PG8_BAR; PG8_SCHED;
            PG8_LDB(B1, 0, 1); PG8_STAGE(PG8_SB(0, 0), b2, voffB);
            PG8_BAR; PG8_WAIT_L(0); PG8_MMA(0, 1, At, B1); PG8_BAR;
            PG8_LDA(At, 0, 1); PG8_STAGE(PG8_SA(0, 0), a2, voffA);
            PG8_BAR; PG8_WAIT_L(0); PG8_MMA(1, 0, At, B0); PG8_BAR; PG8_SCHED;
            PG8_STAGE(PG8_SB(0, 1), b2 + hstep, voffB);
            PG8_WAIT_V(6); PG8_BAR; PG8_MMA(1, 1, At, B1); PG8_BAR;
            PG8_LDB(B0, 1, 0); PG8_SCHED; PG8_LDA(At, 1, 0); PG8_STAGE(PG8_SA(0, 1), a2 + hstep, voffA);
            PG8_WAIT_L(8); PG8_BAR; PG8_WAIT_L(0); PG8_MMA(0, 0, At, B0); PG8_BAR; PG8_SCHED;
            PG8_LDB(B1, 1, 1); PG8_STAGE(PG8_SB(1, 0), b3, voffB);
            PG8_BAR; PG8_WAIT_L(0); PG8_MMA(0, 1, At, B1); PG8_BAR;
            PG8_LDA(At, 1, 1); PG8_STAGE(PG8_SA(1, 0), a3, voffA);
            PG8_BAR; PG8_WAIT_L(0); PG8_MMA(1, 0, At, B0); PG8_BAR; PG8_SCHED;
            PG8_STAGE(PG8_SB(1, 1), b3 + hstep, voffB);
            PG8_WAIT_V(6); PG8_BAR; PG8_MMA(1, 1, At, B1); PG8_BAR;
            }
        }
        if constexpr (ALIGN_EPI) { if (wr == 0) PG8_BAR; }
        if constexpr (!Epi::AFTER_DRAIN) { int l2_ = (int)__builtin_amdgcn_mbcnt_hi(~0u, __builtin_amdgcn_mbcnt_lo(~0u, 0u)); asm volatile("" : "+v"(l2_));
            E(acc, cur, wr, wc, l2_ & 15, l2_ >> 4); S.done(cur); }
        if (!has_next) break;
#pragma unroll
        for (int a = 0; a < 2; ++a)
#pragma unroll
            for (int b = 0; b < 2; ++b)
#pragma unroll
                for (int m = 0; m < 4; ++m)
#pragma unroll
                    for (int n = 0; n < 2; ++n) acc[a][b][m][n] = (f32x4){0.f, 0.f, 0.f, 0.f};
        cur = nxt; cA = nA; cB = nB; ++ui;
        if constexpr (ALIGN_EPI) { if (wr == 1) PG8_BAR; }
    }
    PG8_WAIT_V(0);
    if constexpr (!ALIGN_EPI) { if (wr == 0) PG8_BAR; }
    PG8_BAR;
    if constexpr (Epi::AFTER_DRAIN) { E.fused(acc, cur, wr, wc, fr, fq, lds, wid, lane); S.done(cur); }
#undef PG8_SA
#undef PG8_SB
#undef PG8_STAGE
#undef PG8_LDA
#undef PG8_LDB
#undef PG8_MMA
#undef PG8_LDA8
#undef PG8_LDB8
#undef PG8_MMA8
#undef PG8_MMAI
#undef PG8_STAGE4
#undef PG8_MMAX
#undef PG8_WAIT_V
#undef PG8_WAIT_L
#undef PG8_BAR
#undef PG8_SCHED
}
}

constexpr int SEQ = 8192, DM = 4096, NQH = 32, NKVH = 8, HD = 128, INW = 16384, DFF = 16384, SSMW = 2048, NGRP = 128, NST = 64, NMOD = 6 * DM;
constexpr float EPS = 1e-6f, LOG2E = 1.4426950408889634f;
constexpr int NWAVES = 8, NTHR = 512;

constexpr size_t MiB = 1u << 20;
constexpr size_t WS_CTL = 0, CTL_ZERO_BYTES = MiB / 4;
constexpr size_t WS_MODP = 1 * MiB;
constexpr size_t WS_MOD = 2 * MiB;
constexpr size_t WS_ROPE = 3 * MiB;
constexpr size_t WS_F = 4 * MiB;
constexpr size_t WS_WIN = 16 * MiB, WS_WGLU = 144 * MiB, WS_WOUT = 176 * MiB, WS_WFF1 = 208 * MiB, WS_WFF2 = 336 * MiB;
constexpr size_t WS_H = 464 * MiB;
constexpr size_t WS_Q = 528 * MiB, WS_K = 592 * MiB, WS_V = 608 * MiB;
constexpr size_t WS_U = 624 * MiB;
constexpr size_t WS_GA = 688 * MiB, WS_GS = 752 * MiB;
constexpr size_t WS_ATT = 816 * MiB;
constexpr size_t WS_YG = 880 * MiB;
constexpr size_t WS_MRG = 912 * MiB;
constexpr size_t WS_FFH = 976 * MiB;
constexpr size_t WS_H8 = 1232 * MiB;
constexpr size_t WS_WG8 = WS_WIN;
constexpr size_t WS_WINU = WS_WIN + 64 * MiB;
constexpr size_t WS_HI8 = 1264 * MiB;
constexpr size_t WS_MRGI8 = 1296 * MiB;
constexpr size_t WS_MMAX = 1328 * MiB;
constexpr size_t WS_SAH = 1332 * MiB, WS_SAM = WS_SAH + 65536;
constexpr size_t WS_END = 1333 * MiB;
constexpr size_t WS_WMAXU = WS_CTL + 196608, WS_WMAXO = WS_CTL + 204800;
constexpr size_t WS_BIAS2 = WS_CTL + 65536;
constexpr size_t WS_SSQ = 12 * MiB;
constexpr int CW_BAR = 4096;

constexpr int RING_BYTES = 131072;
constexpr int XCH_OFF = RING_BYTES, XCH_BYTES = 8192;
constexpr int MISC_OFF = 147456;
constexpr int LDS_BYTES = MISC_OFF + 256;

#define GAS __attribute__((address_space(1)))
#define LAS __attribute__((address_space(3)))
typedef unsigned short bf16;
typedef unsigned u32x4 __attribute__((ext_vector_type(4)));
typedef unsigned u32x2 __attribute__((ext_vector_type(2)));
typedef float f32x4 __attribute__((ext_vector_type(4)));
typedef float f32x16 __attribute__((ext_vector_type(16)));
typedef short bf16x8 __attribute__((ext_vector_type(8)));
typedef short s16x4 __attribute__((ext_vector_type(4)));
typedef GAS unsigned gu32;
#define RLX_AGENT __ATOMIC_RELAXED, __HIP_MEMORY_SCOPE_AGENT
#define LDS_WAIT() asm volatile("s_waitcnt lgkmcnt(0)" ::: "memory")
#define VM_WAIT() asm volatile("s_waitcnt vmcnt(0)" ::: "memory")
using pg8::cvt_pk_bf16;
typedef float f32x2 __attribute__((ext_vector_type(2)));
#define XB_TMO      128
#define XB_XCNT(j)  (256  + 64 * (j))
#define XB_XSUB(j)  (1280 + 64 * (j))
#define XB_XGEN(j)  (2304 + 64 * (j))
#define XB_TOP      3328
#define XB_TOPGEN   3392
#define XCD_BAR_WORDS 3456
#define XB_SPIN_CAP (1u << 18)

__device__ __forceinline__ unsigned xb_ld(unsigned* p)              { return __hip_atomic_load(p, __ATOMIC_RELAXED, __HIP_MEMORY_SCOPE_AGENT); }
__device__ __forceinline__ unsigned xb_add(unsigned* p, unsigned v) { return __hip_atomic_fetch_add(p, v, __ATOMIC_RELAXED, __HIP_MEMORY_SCOPE_AGENT); }
__device__ __forceinline__ unsigned xb_xcc_id() { return (unsigned)__builtin_amdgcn_s_getreg((3 << 11) | 20) & 0xFu; }
#define XB_SPIN(cond, bar) do { unsigned _sp = 0; while (cond) { __builtin_amdgcn_s_sleep(1); \
    if ((++_sp & 255u) == 0u) { if (xb_ld(&(bar)[XB_TMO])) break; if (_sp > XB_SPIN_CAP) { atomicAdd(&(bar)[XB_TMO], 1u); break; } } } } while (0)

struct XcdBarrier {
    unsigned* bar; unsigned x; int wave;
    volatile LAS unsigned* st;
};

__device__ __forceinline__ int xb_lane_id() { return (int)__builtin_amdgcn_mbcnt_hi(~0u, __builtin_amdgcn_mbcnt_lo(~0u, 0u)); }
__device__ __forceinline__ XcdBarrier xcd_barrier_post(unsigned* bar, volatile LAS unsigned* st) {
    XcdBarrier b; b.bar = bar; b.x = xb_xcc_id(); b.st = st; b.wave = __builtin_amdgcn_readfirstlane((int)(threadIdx.x >> 6));
    if (threadIdx.x == 0) (void)xb_add(&bar[XB_XCNT(b.x)], 1u);
    return b;
}
__device__ __forceinline__ void xcd_barrier_complete(unsigned* bar, unsigned x, unsigned& nloc, unsigned& nx) {
    const unsigned G = gridDim.x * gridDim.y * gridDim.z;
    unsigned sum, cnt, mine, sp = 0u;
    for (;;) {
        sum = 0u; cnt = 0u; mine = 0u;
#pragma unroll
        for (unsigned j = 0; j < 16; ++j) { const unsigned c = xb_ld(&bar[XB_XCNT(j)]); sum += c; cnt += (c > 0u) ? 1u : 0u; mine = (j == x) ? c : mine; }
        if (sum == G) break;
        __builtin_amdgcn_s_sleep(1);
        if ((++sp & 255u) == 0u) { if (xb_ld(&bar[XB_TMO])) break; if (sp > XB_SPIN_CAP) { atomicAdd(&bar[XB_TMO], 1u); break; } }
    }
    nloc = mine > 0u ? mine : 1u; nx = cnt > 0u ? cnt : 1u;
}

__device__ __forceinline__ void xcd_barrier(const XcdBarrier& b) {
    asm volatile("s_waitcnt vmcnt(0)" ::: "memory");
    __syncthreads();
    if (b.wave == 0 && xb_lane_id() == 0) {
        unsigned* bar = b.bar;
        __builtin_amdgcn_s_waitcnt(0);
        unsigned nloc = b.st[0], nx = b.st[1];
        if (nloc == 0u) { xcd_barrier_complete(bar, b.x, nloc, nx); b.st[0] = nloc; b.st[1] = nx; }
        const unsigned old = xb_add(&bar[XB_XSUB(b.x)], 1u);
        const unsigned gen = old / nloc;
        if (old + 1u == (gen + 1u) * nloc) {
            __builtin_amdgcn_fence(__ATOMIC_RELEASE, "agent");
            asm volatile("s_waitcnt vmcnt(0)" ::: "memory");
            const unsigned og = xb_add(&bar[XB_TOP], 1u);
            const unsigned tg = og / nx;
            if (og + 1u == (tg + 1u) * nx) xb_add(&bar[XB_TOPGEN], 1u);
            else XB_SPIN(xb_ld(&bar[XB_TOPGEN]) == tg, bar);
            __builtin_amdgcn_fence(__ATOMIC_ACQUIRE, "agent");
            xb_add(&bar[XB_XGEN(b.x)], 1u);
            asm volatile("s_waitcnt vmcnt(0)" ::: "memory");
        } else {
            XB_SPIN(xb_ld(&bar[XB_XGEN(b.x)]) == gen, bar);
            __builtin_amdgcn_fence(__ATOMIC_ACQUIRE, "agent");
            asm volatile("s_waitcnt vmcnt(0)" ::: "memory");
        }
    }
    __syncthreads();
}

__device__ __forceinline__ float wave_sum(float v) {
#pragma unroll
    for (int o = 1; o < 64; o <<= 1) v += __shfl_xor(v, o);
    return v;
}
__device__ __forceinline__ int inv_perm32(int l) { return 16 * ((l >> 2) & 1) + 4 * (l >> 3) + (l & 3); }
template <int MODE> __device__ __forceinline__ int phys_row(int n) {
    if (MODE == 1 && n < 5120) return n;
    if (MODE == 2) { const int bj = n >> 12, ch = n & 4095; return 256 * (ch >> 7) + 128 * bj + (ch & 96) + inv_perm32(ch & 31); }
    return (n & ~31) + inv_perm32(n & 31);
}
using pg8::pk4_i8;
__device__ __forceinline__ float i8f(unsigned w, int i) { return (float)((int)(w << (24 - 8 * i)) >> 24); }
struct TrItem { const float* W; bf16* WT; int K, N, mode, k0, n0, fp8, i8; const unsigned* wmax; const float* addv; float* bias; const float* rowscale; };
__device__ __forceinline__ int phys_row_rt(int mode, int n) {
    if (mode == 1 && n < 5120) return n;
    if (mode == 2) { const int bj = n >> 12, ch = n & 4095; return 256 * (ch >> 7) + 128 * bj + (ch & 96) + inv_perm32(ch & 31); }
    return (n & ~31) + inv_perm32(n & 31);
}
__device__ __forceinline__ void tr_load(const TrItem& d, float (&v)[64], int lane) {
    const float* src = d.W + (size_t)d.k0 * d.N + d.n0 + lane;
#pragma unroll
    for (int i = 0; i < 64; ++i) v[i] = __builtin_nontemporal_load(src + (size_t)i * d.N);
}
__device__ __forceinline__ void tr_finish(const TrItem& d, const float (&v)[64], LAS float* scr, int lane) {
    if (d.bias) { float s = 0.f;
#pragma unroll
        for (int i = 0; i < 64; ++i) s += d.addv[d.k0 + i] * v[i];
        atomicAdd(d.bias + d.n0 + lane, s); }
    if (d.i8) {
        const float cm = __uint_as_float(d.wmax[(d.mode == 5 ? d.n0 - 6144 : d.n0) + lane]), inv = cm > 0.f ? 127.0f / cm : 0.f;
#pragma unroll
        for (int i = 0; i < 64; ++i) scr[i * 65 + lane] = v[i] * inv;
        LDS_WAIT();
        const int c8 = lane & 7;
#pragma unroll
        for (int j = 0; j < 8; ++j) { const int n = (lane >> 3) + 8 * j; const LAS float* s = scr + (8 * c8) * 65 + n;
            u32x2 o; o.x = pk4_i8(s[0 * 65], s[1 * 65], s[2 * 65], s[3 * 65]); o.y = pk4_i8(s[4 * 65], s[5 * 65], s[6 * 65], s[7 * 65]);
            const int row = d.mode == 5 ? phys_row_rt(0, d.n0 - 6144 + n) : phys_row_rt(d.mode, d.n0 + n);
            *(u32x2*)((unsigned char*)d.WT + (size_t)row * d.K + d.k0 + 8 * c8) = o; }
        LDS_WAIT(); return;
    }
    if (d.rowscale) {
#pragma unroll
        for (int i = 0; i < 64; ++i) scr[i * 65 + lane] = v[i] * d.rowscale[d.k0 + i];
    } else {
#pragma unroll
        for (int i = 0; i < 64; ++i) scr[i * 65 + lane] = v[i];
    }
    LDS_WAIT();
    const int c = lane & 7;
    if (d.fp8) {
#pragma unroll
        for (int j = 0; j < 8; ++j) { const int n = (lane >> 3) + 8 * j; const LAS float* s = scr + (8 * c) * 65 + n;
            u32x2 o; o.x = pg8::pk4_fp8(s[0 * 65] * pg8::W8_SCALE, s[1 * 65] * pg8::W8_SCALE, s[2 * 65] * pg8::W8_SCALE, s[3 * 65] * pg8::W8_SCALE);
            o.y = pg8::pk4_fp8(s[4 * 65] * pg8::W8_SCALE, s[5 * 65] * pg8::W8_SCALE, s[6 * 65] * pg8::W8_SCALE, s[7 * 65] * pg8::W8_SCALE);
            const int nn = d.n0 + n, row = d.mode != 3 ? phys_row_rt(d.mode, nn) : (nn < 6144 ? phys_row_rt(1, nn) : 6144 + phys_row_rt(0, nn - 8192));
            *(u32x2*)((unsigned char*)d.WT + (size_t)row * d.K + d.k0 + 8 * c) = o; }
        LDS_WAIT(); return;
    }
#pragma unroll
    for (int j = 0; j < 8; ++j) { const int n = (lane >> 3) + 8 * j; const LAS float* s = scr + (8 * c) * 65 + n;
        u32x4 o; o.x = cvt_pk_bf16(s[0 * 65], s[1 * 65]); o.y = cvt_pk_bf16(s[2 * 65], s[3 * 65]); o.z = cvt_pk_bf16(s[4 * 65], s[5 * 65]); o.w = cvt_pk_bf16(s[6 * 65], s[7 * 65]);
        const int row = d.mode == 5 ? phys_row_rt(0, d.n0 - 6144 + n) : phys_row_rt(d.mode, d.n0 + n);
        *(u32x4*)(d.WT + (size_t)row * d.K + d.k0 + 8 * c) = o; }
    LDS_WAIT();
}

struct Ptrs {
    const float *x, *c, *w_ada, *b_ada, *n1g, *n2g, *w_in, *qng, *kng, *sinks, *lam_re, *lam_im, *log_dt, *b_re, *b_im, *c_re, *c_im, *dsk, *w_glu, *w_out, *w_ff1, *w_ff2;
    const int* pos; float* out;
    float *MODP, *MOD, *ROPE, *F, *BIAS2, *SSQ;
    unsigned char *H8, *WG8, *HI8, *MRGI8; bf16* WINU; float *MMAX, *SAH, *SAM; unsigned *WMAXU, *WMAXO;
    bf16 *WIN, *WGLU, *WOUT, *WFF1, *WFF2, *H, *Q, *K, *V, *ATT, *YG, *FFH, *U; unsigned char *GA, *GS, *MRG;
};

constexpr int TI_IN = (DM / 64) * 224;
constexpr int TI_U = (DM / 64) * 32;
constexpr int TI_CM = TI_U + (DM / 64) * (DM / 64);
constexpr int TI_GLU = (SSMW / 64) * (2 * DM / 64), TI_OUT = (DM / 64) * (DM / 64), TI_FF1 = (DM / 64) * (DFF / 64), TI_FF2 = (DFF / 64) * (DM / 64), TI_ALL = TI_GLU + TI_OUT + TI_FF1 + TI_FF2;
template <int LIST> __device__ __forceinline__ TrItem tr_decode(const Ptrs& P, int r) {
    TrItem d; d.addv = nullptr; d.bias = nullptr; d.fp8 = 0; d.rowscale = nullptr; d.i8 = 0; d.wmax = nullptr;
    if (LIST == 0 || LIST == 2) { d.W = P.w_in; d.WT = P.WIN; d.K = DM; d.N = INW; d.mode = 1; }
    else if (r < TI_GLU) { d.W = P.w_glu; d.WT = P.WGLU; d.K = SSMW; d.N = 2 * DM; d.mode = 2; d.fp8 = 1; }
    else if (r < TI_GLU + TI_OUT) { r -= TI_GLU; d.W = P.w_out; d.WT = P.WOUT; d.K = DM; d.N = DM; d.mode = 0; d.i8 = 1; d.wmax = P.WMAXO; }
    else if (r < TI_GLU + TI_OUT + TI_FF1) { r -= TI_GLU + TI_OUT; d.W = P.w_ff1; d.WT = P.WFF1; d.K = DM; d.N = DFF; d.mode = 0; d.addv = P.MOD + 3 * DM; d.bias = P.BIAS2; d.rowscale = P.MOD + 6 * DM; }
    else { r -= TI_GLU + TI_OUT + TI_FF1; d.W = P.w_ff2; d.WT = P.WFF2; d.K = DFF; d.N = DM; d.mode = 0; }
    if (LIST == 0) { const int nb = r % 224; d.k0 = 64 * (r / 224); d.n0 = 64 * (nb < 96 ? nb : nb + 32); d.mode = 3; d.fp8 = 1; d.WT = (bf16*)P.WG8; }
    else if (LIST == 2) { d.k0 = 64 * (r / 32); d.n0 = 6144 + 64 * (r % 32); d.mode = 5; d.i8 = 1; d.wmax = P.WMAXU; d.WT = P.WINU; }
    else { const int nblk = d.N / 64; d.k0 = 64 * (r / nblk); d.n0 = 64 * (r % nblk); }
    return d;
}
__device__ __forceinline__ int pool_grab(LAS unsigned* ctr, int lo, int lane) {
    unsigned k = 0u; if (lane == 0) k = __hip_atomic_fetch_add(ctr, 1u, __ATOMIC_RELAXED, __HIP_MEMORY_SCOPE_WORKGROUP);
    return lo + (int)__builtin_amdgcn_readfirstlane(k);
}
template <int LIST> __device__ __forceinline__ void transpose_pool(const Ptrs& P, int lo, int hi, LAS unsigned* ctr, LAS float* scr, int lane) {
    float va[64], vb[64];
    int r0 = pool_grab(ctr, lo, lane); if (r0 >= hi) return;
    TrItem d0 = tr_decode<LIST>(P, r0), d1 = d0; tr_load(d0, va, lane);
    for (;;) {
        const int r1 = pool_grab(ctr, lo, lane);
        if (r1 < hi) { d1 = tr_decode<LIST>(P, r1); tr_load(d1, vb, lane); }
        tr_finish(d0, va, scr, lane);
        if (r1 >= hi) break;
        r0 = pool_grab(ctr, lo, lane);
        if (r0 < hi) { d0 = tr_decode<LIST>(P, r0); tr_load(d0, va, lane); }
        tr_finish(d1, vb, scr, lane);
        if (r0 >= hi) break;
    }
}

__device__ __forceinline__ void phase0(const Ptrs& P, LAS unsigned char* lds, int bx, int G, int tid, int wave, int lane) {
    LAS float* red = (LAS float*)lds;
    for (int j = bx; j < 96 * 8; j += G) {
        const int chunk = j % 96, kg = j / 96, k0 = kg * 512 + wave * 64;
        float cv = P.c[k0 + lane]; cv = cv / (1.0f + expf(-cv));
        f32x4 acc = {0.f, 0.f, 0.f, 0.f};
        const float* wp = P.w_ada + (size_t)k0 * NMOD + chunk * 256 + lane * 4;
#pragma unroll 16
        for (int kk = 0; kk < 64; ++kk) { const f32x4 w = __builtin_nontemporal_load((const f32x4*)(wp + (size_t)kk * NMOD)); const float a = __int_as_float(__builtin_amdgcn_readlane(__float_as_int(cv), kk)); acc += w * a; }
        *(LAS f32x4*)(red + wave * 256 + lane * 4) = acc;
        __syncthreads();
        if (tid < 256) { float s = 0.f;
#pragma unroll
            for (int w = 0; w < 8; ++w) s += red[w * 256 + tid];
            P.MODP[(size_t)kg * NMOD + chunk * 256 + tid] = s; }
        __syncthreads();
    }
    { const int gwc = bx * NWAVES + wave, NGWC = G * NWAVES;
      for (int it = gwc; it < TI_CM; it += NGWC) {
          const bool isu = it < TI_U; const int r = isu ? it : it - TI_U, nblk = isu ? 32 : DM / 64, N = isu ? INW : DM;
          const int k0 = 64 * (r / nblk), nb = r % nblk, n0 = isu ? 6144 + 64 * nb : 64 * nb;
          const float* src = (isu ? P.w_in : P.w_out) + (size_t)k0 * N + n0 + lane;
          float m0 = 0.f, m1 = 0.f;
#pragma unroll 16
          for (int i = 0; i < 64; i += 2) { m0 = fmaxf(m0, fabsf(__builtin_nontemporal_load(src + (size_t)i * N))); m1 = fmaxf(m1, fabsf(__builtin_nontemporal_load(src + (size_t)(i + 1) * N))); }
          atomicMax((isu ? P.WMAXU : P.WMAXO) + 64 * nb + lane, __float_as_uint(fmaxf(m0, m1)));
      } }
    { const int per = (TI_IN + G - 1) / G, lo = bx * per, hi = (lo + per < TI_IN) ? lo + per : TI_IN;
      transpose_pool<0>(P, lo, hi, (LAS unsigned*)(lds + MISC_OFF) + 18, (LAS float*)(lds + wave * 16640), lane); }
}

__device__ __forceinline__ void norm_row(const float* xrow, unsigned char* orow8, unsigned char* orowi, float* sa, const LAS float* mult, const LAS float* add, int lane) {
    const f32x4* xr = (const f32x4*)xrow + lane;
    f32x4 v[16]; float ss = 0.f;
#pragma unroll
    for (int j = 0; j < 16; ++j) { v[j] = xr[64 * j]; ss += (v[j][0] * v[j][0] + v[j][1] * v[j][1]) + (v[j][2] * v[j][2] + v[j][3] * v[j][3]); }
    const float rstd = 1.0f / sqrtf(wave_sum(ss) * (1.0f / DM) + EPS);
    float am = 0.f;
#pragma unroll
    for (int j = 0; j < 16; ++j) { const f32x4 m = *(const LAS f32x4*)(mult + 4 * lane + 256 * j), a = *(const LAS f32x4*)(add + 4 * lane + 256 * j);
        v[j] = v[j] * rstd * m + a; am = fmaxf(fmaxf(am, fmaxf(fabsf(v[j][0]), fabsf(v[j][1]))), fmaxf(fabsf(v[j][2]), fabsf(v[j][3])));
        if ((j & 3) == 3) asm volatile("" ::: "memory"); }
#pragma unroll
    for (int o = 1; o < 64; o <<= 1) am = fmaxf(am, __shfl_xor(am, o));
    const float inv = am > 0.f ? 127.0f / am : 0.f;
    if (lane == 0) *sa = am * (1.0f / 127.0f);
    unsigned* o4 = (unsigned*)orow8 + lane; unsigned* oi = (unsigned*)orowi + lane;
#pragma unroll
    for (int j = 0; j < 16; ++j) { const f32x4 y = v[j]; o4[64 * j] = pg8::pk4_fp8(y[0], y[1], y[2], y[3]); oi[64 * j] = pk4_i8(y[0] * inv, y[1] * inv, y[2] * inv, y[3] * inv); }
}
__device__ __forceinline__ void quant_row(const unsigned char* mrow, const float* pmax, unsigned char* orowi, float* sa, int lane) {
    float am = fmaxf(pmax[lane], pmax[64 + lane]);
#pragma unroll
    for (int o = 1; o < 64; o <<= 1) am = fmaxf(am, __shfl_xor(am, o));
    const float inv = am > 0.f ? 1.0f / am : 0.f;
    if (lane == 0) *sa = am * (1.0f / 127.0f);
    const u32x4* mr = (const u32x4*)mrow + lane; u32x4* oi = (u32x4*)orowi + lane;
    u32x4 w[4]; float f[4];
#pragma unroll
    for (int j = 0; j < 4; ++j) { w[j] = mr[64 * j]; f[j] = pmax[(lane >> 1) + 32 * j] * inv; }
#pragma unroll
    for (int j = 0; j < 4; ++j) { u32x4 o;
#pragma unroll
        for (int c = 0; c < 4; ++c) { const unsigned x = w[j][c]; o[c] = pk4_i8(i8f(x, 0) * f[j], i8f(x, 1) * f[j], i8f(x, 2) * f[j], i8f(x, 3) * f[j]); }
        oi[64 * j] = o; }
}

__device__ __forceinline__ void phase1(const Ptrs& P, LAS unsigned char* lds, int bx, int G, int tid, int wave, int lane) {
    LAS float* mult = (LAS float*)lds; LAS float* add = mult + DM;
    for (int c = tid; c < DM; c += NTHR) {
        float sh = P.b_ada[c], sc = P.b_ada[DM + c];
#pragma unroll
        for (int p = 0; p < 8; ++p) { sh += P.MODP[(size_t)p * NMOD + c]; sc += P.MODP[(size_t)p * NMOD + DM + c]; }
        mult[c] = P.n1g[c] * (1.0f + sc); add[c] = sh;
    }
    for (int col = bx * NTHR + tid; col < NMOD; col += G * NTHR) {
        float s = P.b_ada[col];
#pragma unroll
        for (int p = 0; p < 8; ++p) s += P.MODP[(size_t)p * NMOD + col];
        P.MOD[col] = s;
        if (col >= 4 * DM && col < 5 * DM) P.MOD[6 * DM + (col - 4 * DM)] = P.n2g[col - 4 * DM] * (1.0f + s);
    }
    const int gw = bx * NWAVES + wave, NGW = G * NWAVES;
    for (int r4 = gw; r4 < SEQ / 4; r4 += NGW) {
        const int row = r4 * 4 + (lane >> 4), i = lane & 15;
        const float inv_freq = powf(500000.0f, -2.0f * (float)i / 32.0f);
        const float ang = (float)P.pos[row] * inv_freq;
        P.ROPE[(size_t)row * 32 + i] = cosf(ang); P.ROPE[(size_t)row * 32 + 16 + i] = sinf(ang);
    }
    __syncthreads();
    for (int row = gw; row < SEQ; row += NGW) norm_row(P.x + (size_t)row * DM, P.H8 + (size_t)row * DM, P.HI8 + (size_t)row * DM, P.SAH + row, mult, add, lane);
    { const int per = (TI_U + G - 1) / G, lo = bx * per, hi = (lo + per < TI_U) ? lo + per : TI_U;
      __syncthreads();
      transpose_pool<2>(P, lo, hi, (LAS unsigned*)(lds + MISC_OFF) + 19, (LAS float*)(lds + wave * 16640), lane); }
}
__device__ __forceinline__ int crow(int r, int h) { return (r & 3) + 8 * (r >> 2) + 4 * h; }
#define MFMA32(a, b, c) __builtin_amdgcn_mfma_f32_32x32x16_bf16((a), (b), (c), 0, 0, 0)
#define MFMA16(a, b, c) __builtin_amdgcn_mfma_f32_16x16x32_bf16((a), (b), (c), 0, 0, 0)
constexpr int ATT_KP = 272, ATT_VP = 520, ATT_VOFF = 256 * ATT_KP;
static_assert(ATT_VOFF + 128 * ATT_VP <= MISC_OFF, "attention LDS");
__device__ __forceinline__ void attn_unit(const Ptrs& P, int qb, int kh, LAS unsigned char* lds, int tid, int wave, int lane) {
    const bool hasprev = qb > 0;
#pragma unroll
    for (int i = 0; i < 8; ++i) {
        const int c = tid + NTHR * i, key = c >> 4, part = c & 15; u32x4 v = {0u, 0u, 0u, 0u};
        if (hasprev || key >= 128) v = *(const u32x4*)(P.K + (size_t)(128 * (qb - 1) + key) * 1024 + kh * 128 + part * 8);
        *(LAS u32x4*)(lds + key * ATT_KP + part * 16) = v;
    }
#pragma unroll
    for (int i = 0; i < 8; ++i) {
        const int c = tid + NTHR * i, key = c & 255, part = c >> 8; u32x4 v = {0u, 0u, 0u, 0u};
        if (hasprev || key >= 128) v = *(const u32x4*)(P.V + (size_t)(128 * (qb - 1) + key) * 1024 + kh * 128 + part * 8);
#pragma unroll
        for (int e = 0; e < 8; ++e) *(LAS unsigned short*)(lds + ATT_VOFF + (part * 8 + e) * ATT_VP + key * 2) = (unsigned short)((v[e >> 1] >> (16 * (e & 1))) & 0xffffu);
    }
    __syncthreads();
    const int hq = 4 * kh + (wave >> 1), qh = wave & 1, r = lane & 31, h = lane >> 5;
    const float sink2 = P.sinks[hq] * LOG2E;
    const float NEG = -__builtin_inff();
#pragma unroll 1
    for (int qq = 0; qq < 2; ++qq) {
        const int i0 = 64 * qh + 32 * qq;
        const size_t qrow = (size_t)(128 * qb + i0 + r);
        bf16x8 qf[8];
#pragma unroll
        for (int ks = 0; ks < 8; ++ks) qf[ks] = *(const bf16x8*)(P.Q + qrow * 4096 + hq * 128 + 16 * ks + 8 * h);
        f32x16 st[5];
#pragma unroll
        for (int t = 0; t < 5; ++t) {
#pragma unroll
            for (int e = 0; e < 16; ++e) st[t][e] = 0.f;
#pragma unroll
            for (int ks = 0; ks < 8; ++ks) { const bf16x8 kf = *(const LAS bf16x8*)(lds + (i0 + 32 * t + r) * ATT_KP + (16 * ks + 8 * h) * 2); st[t] = MFMA32(kf, qf[ks], st[t]); }
        }
#pragma unroll
        for (int e = 0; e < 16; ++e) { const int cr = crow(e, h); if (cr <= r) st[0][e] = NEG; if (cr > r) st[4][e] = NEG; }
        if (!hasprev) {
#pragma unroll
            for (int t = 0; t < 5; ++t) if (i0 + 32 * t < 128) {
#pragma unroll
                for (int e = 0; e < 16; ++e) st[t][e] = NEG; }
        }
        float m = sink2;
#pragma unroll
        for (int t = 0; t < 5; ++t)
#pragma unroll
            for (int e = 0; e < 16; ++e) m = fmaxf(m, st[t][e]);
        m = fmaxf(m, __shfl_xor(m, 32));
        float l = 0.f;
#pragma unroll
        for (int t = 0; t < 5; ++t)
#pragma unroll
            for (int e = 0; e < 16; ++e) { const float p = __builtin_amdgcn_exp2f(st[t][e] - m); st[t][e] = p; l += p; }
        l += __shfl_xor(l, 32);
        l += __builtin_amdgcn_exp2f(sink2 - m);
        bf16x8 pf[5][2];
#pragma unroll
        for (int t = 0; t < 5; ++t)
#pragma unroll
            for (int s = 0; s < 2; ++s) { u32x4 w; w.x = cvt_pk_bf16(st[t][8 * s + 0], st[t][8 * s + 1]); w.y = cvt_pk_bf16(st[t][8 * s + 2], st[t][8 * s + 3]); w.z = cvt_pk_bf16(st[t][8 * s + 4], st[t][8 * s + 5]); w.w = cvt_pk_bf16(st[t][8 * s + 6], st[t][8 * s + 7]);
                pf[t][s] = __builtin_bit_cast(bf16x8, w); }
        const float inv = (1.0f / 255.0f) / l;
#pragma unroll
        for (int db = 0; db < 4; ++db) {
            f32x16 o;
#pragma unroll
            for (int e = 0; e < 16; ++e) o[e] = 0.f;
#pragma unroll
            for (int t = 0; t < 5; ++t)
#pragma unroll
                for (int s = 0; s < 2; ++s) {
                    const LAS unsigned char* vp = lds + ATT_VOFF + (32 * db + r) * ATT_VP + (i0 + 32 * t + 16 * s + 4 * h) * 2;
                    const s16x4 lo = *(const LAS s16x4*)vp, hi = *(const LAS s16x4*)(vp + 16);
                    const bf16x8 vf = __builtin_shufflevector(lo, hi, 0, 1, 2, 3, 4, 5, 6, 7);
                    o = MFMA32(vf, pf[t][s], o);
                }
            unsigned gav[4];
#pragma unroll
            for (int g4 = 0; g4 < 4; ++g4) gav[g4] = *(const unsigned*)(P.GA + qrow * 4096 + hq * 128 + 32 * db + 8 * g4 + 4 * h);
#pragma unroll
            for (int g4 = 0; g4 < 4; ++g4) { u32x2 w;
                w.x = cvt_pk_bf16(o[4 * g4 + 0] * inv * pg8::u8f(gav[g4], 0), o[4 * g4 + 1] * inv * pg8::u8f(gav[g4], 1)); w.y = cvt_pk_bf16(o[4 * g4 + 2] * inv * pg8::u8f(gav[g4], 2), o[4 * g4 + 3] * inv * pg8::u8f(gav[g4], 3));
                *(u32x2*)(P.ATT + qrow * 4096 + hq * 128 + 32 * db + 8 * g4 + 4 * h) = w; }
        }
    }
    __syncthreads();
}

constexpr int SSM_L = 512, SSM_NSC = SEQ / SSM_L;
constexpr int SSM_WL = 16640;
static_assert(NWAVES * SSM_WL <= MISC_OFF, "ssm LDS");
__device__ __forceinline__ void split_bf16(const f32x4 a, const f32x4 b, bf16x8& hi, bf16x8& lo) {
    u32x4 wh; wh.x = cvt_pk_bf16(a[0], a[1]); wh.y = cvt_pk_bf16(a[2], a[3]); wh.z = cvt_pk_bf16(b[0], b[1]); wh.w = cvt_pk_bf16(b[2], b[3]);
    f32x4 ra, rb; ra[0] = a[0] - pg8::bf_lo(wh.x); ra[1] = a[1] - pg8::bf_hi(wh.x); ra[2] = a[2] - pg8::bf_lo(wh.y); ra[3] = a[3] - pg8::bf_hi(wh.y);
    rb[0] = b[0] - pg8::bf_lo(wh.z); rb[1] = b[1] - pg8::bf_hi(wh.z); rb[2] = b[2] - pg8::bf_lo(wh.w); rb[3] = b[3] - pg8::bf_hi(wh.w);
    u32x4 wl; wl.x = cvt_pk_bf16(ra[0], ra[1]); wl.y = cvt_pk_bf16(ra[2], ra[3]); wl.z = cvt_pk_bf16(rb[0], rb[1]); wl.w = cvt_pk_bf16(rb[2], rb[3]);
    hi = __builtin_bit_cast(bf16x8, wh); lo = __builtin_bit_cast(bf16x8, wl);
}
template <bool PASS2> __device__ __forceinline__ void ssm_unit(const Ptrs& P, int sc, int g, LAS unsigned char* wl, int lane) {
    const int p = lane, fr = lane & 15, fq = lane >> 4;
    LAS float* R = (LAS float*)wl;
    const float dt = expf(P.log_dt[g]);
    const float lr = P.lam_re[g * NST + p], li = P.lam_im[g * NST + p];
    const float mag = expf(lr * dt), ar = mag * cosf(li * dt), ai = mag * sinf(li * dt);
    const float den = lr * lr + li * li, nr = ar - 1.0f;
    const float cre = (nr * lr + ai * li) / den, cim = (ai * lr - nr * li) / den;
#pragma unroll
    for (int q = 0; q < 4; ++q) { const f32x4 br = *(const f32x4*)(P.b_re + (size_t)(g * NST + p) * 16 + 4 * q), bi = *(const f32x4*)(P.b_im + (size_t)(g * NST + p) * 16 + 4 * q);
        *(LAS f32x4*)(R + p * 20 + 4 * q) = br * cre - bi * cim; *(LAS f32x4*)(R + (64 + p) * 20 + 4 * q) = bi * cre + br * cim; }
    LDS_WAIT();
    bf16x8 bhi[8], blo[8];
#pragma unroll
    for (int j = 0; j < 8; ++j) { const f32x4 a = *(const LAS f32x4*)(R + (16 * j + fr) * 20 + 8 * (fq & 1)), b = *(const LAS f32x4*)(R + (16 * j + fr) * 20 + 8 * (fq & 1) + 4);
        split_bf16(a, b, bhi[j], blo[j]); if (fq >= 2) blo[j] = (bf16x8){0, 0, 0, 0, 0, 0, 0, 0}; }
    LDS_WAIT();
    float sr = 0.f, si = 0.f;
    bf16x8 chi[4], clo[4]; f32x4 dv = {0.f, 0.f, 0.f, 0.f};
    if (PASS2) {
        float pr = ar, pi = ai;
#pragma unroll
        for (int k = 0; k < 9; ++k) { const float t = pr * pr - pi * pi; pi = 2.0f * pr * pi; pr = t; }
        const f32x2* Fp = (const f32x2*)P.F + (size_t)g * NST + p;
        for (int c0 = 0; c0 < sc; c0 += 8) {
            f32x2 f[8];
#pragma unroll
            for (int k = 0; k < 8; ++k) { f[k] = (f32x2){0.f, 0.f}; if (c0 + k < sc) f[k] = Fp[(size_t)(c0 + k) * NGRP * NST]; }
#pragma unroll
            for (int k = 0; k < 8; ++k) if (c0 + k < sc) { const float t = pr * sr - pi * si + f[k][0]; si = pr * si + pi * sr + f[k][1]; sr = t; }
        }
#pragma unroll
        for (int kk = 0; kk < 4; ++kk) { const float* cp = (kk < 2 ? P.c_re : P.c_im) + (size_t)(g * 16 + fr) * NST + 32 * (kk & 1) + 8 * fq;
            f32x4 a = *(const f32x4*)cp, b = *(const f32x4*)(cp + 4); if (kk >= 2) { a = -a; b = -b; }
            split_bf16(a, b, chi[kk], clo[kk]); }
        dv = *(const f32x4*)(P.dsk + 16 * g + 4 * fq);
    }
    const bf16* up = P.U + (size_t)(SSM_L * sc + fr) * SSMW + 16 * g;
    u32x4 uab = *(const u32x4*)(up + 8 * (fq & 1)); u32x2 uc = {0u, 0u};
    if (PASS2) uc = *(const u32x2*)(up + 4 * fq);
#pragma unroll 1
    for (int sb = 0; sb < SSM_L / 16; ++sb) {
        const bf16x8 af = fq < 2 ? __builtin_bit_cast(bf16x8, uab) : (bf16x8){0, 0, 0, 0, 0, 0, 0, 0};
        const f32x4 ucur = {pg8::bf_lo(uc.x), pg8::bf_hi(uc.x), pg8::bf_lo(uc.y), pg8::bf_hi(uc.y)};
        if (sb + 1 < SSM_L / 16) { const bf16* un = up + (size_t)(16 * (sb + 1)) * SSMW;
            uab = *(const u32x4*)(un + 8 * (fq & 1)); if (PASS2) uc = *(const u32x2*)(un + 4 * fq); }
#pragma unroll
        for (int j = 0; j < 8; ++j) { f32x4 d = {0.f, 0.f, 0.f, 0.f}; d = MFMA16(af, bhi[j], d); d = MFMA16(af, blo[j], d); *(LAS f32x4*)(R + (16 * j + fr) * 20 + 4 * fq) = d; }
        LDS_WAIT();
        f32x4 bre[4], bim[4];
#pragma unroll
        for (int q = 0; q < 4; ++q) { bre[q] = *(const LAS f32x4*)(R + p * 20 + 4 * q); bim[q] = *(const LAS f32x4*)(R + (64 + p) * 20 + 4 * q); }
        LDS_WAIT();
#pragma unroll
        for (int q = 0; q < 4; ++q)
#pragma unroll
            for (int x = 0; x < 4; ++x) { const float nsr = ar * sr - ai * si + bre[q][x], nsi = ar * si + ai * sr + bim[q][x]; sr = nsr; si = nsi;
                if (PASS2) { R[(4 * q + x) * 132 + p] = sr; R[(4 * q + x) * 132 + 64 + p] = si; } }
        if (PASS2) {
            LDS_WAIT();
            f32x4 y = {0.f, 0.f, 0.f, 0.f};
#pragma unroll
            for (int kk = 0; kk < 4; ++kk) { const f32x4 a = *(const LAS f32x4*)(R + fr * 132 + 32 * kk + 8 * fq), b = *(const LAS f32x4*)(R + fr * 132 + 32 * kk + 8 * fq + 4);
                bf16x8 shi, slo; split_bf16(a, b, shi, slo);
                y = MFMA16(chi[kk], shi, y); y = MFMA16(chi[kk], slo, y); y = MFMA16(clo[kk], shi, y); }
            y = y + dv * ucur;
            f32x4 o;
#pragma unroll
            for (int j = 0; j < 4; ++j) { const float v = y[j], z = 0.7978845608028654f * (v + 0.044715f * v * v * v); o[j] = v * __builtin_amdgcn_rcpf(1.0f + __builtin_amdgcn_exp2f(-2.0f * LOG2E * z)); }
            *(unsigned*)((unsigned char*)P.YG + (size_t)(SSM_L * sc + 16 * sb + fr) * SSMW + 16 * g + 4 * fq) = pg8::pk4_fp8(o[0], o[1], o[2], o[3]);
            LDS_WAIT();
        }
    }
    if (!PASS2) ((f32x2*)P.F)[(size_t)(sc * NGRP + g) * NST + p] = (f32x2){sr, si};
    LDS_WAIT();
}

struct Args { const void* in[23]; float* out; unsigned char* ws; };
__global__ void __launch_bounds__(NTHR, 2) mk_fwd(Args args) {
    extern __shared__ __attribute__((aligned(16))) unsigned char lds_raw[];
    LAS unsigned char* lds = (LAS unsigned char*)lds_raw;
    volatile LAS unsigned* MISC = (volatile LAS unsigned*)(lds + MISC_OFF);
    const int G = gridDim.x, bx = blockIdx.x;
#define FRESH_IDS() int lane = xb_lane_id(); asm volatile("" : "+v"(lane)); const int wave = bar.wave, tid = wave * 64 + lane; (void)tid
#define MAKE_PTRS() \
    const __attribute__((address_space(4))) Args* ap_ = (const __attribute__((address_space(4))) Args*)__builtin_amdgcn_kernarg_segment_ptr(); asm volatile("" : "+s"(ap_)); \
    unsigned char* ws = ap_->ws; Ptrs P; \
    P.x = (const float*)ap_->in[0]; P.c = (const float*)ap_->in[1]; P.pos = (const int*)ap_->in[2]; P.w_ada = (const float*)ap_->in[3]; P.b_ada = (const float*)ap_->in[4]; \
    P.n1g = (const float*)ap_->in[5]; P.n2g = (const float*)ap_->in[6]; P.w_in = (const float*)ap_->in[7]; P.qng = (const float*)ap_->in[8]; P.kng = (const float*)ap_->in[9]; \
    P.sinks = (const float*)ap_->in[10]; P.lam_re = (const float*)ap_->in[11]; P.lam_im = (const float*)ap_->in[12]; P.log_dt = (const float*)ap_->in[13]; \
    P.b_re = (const float*)ap_->in[14]; P.b_im = (const float*)ap_->in[15]; P.c_re = (const float*)ap_->in[16]; P.c_im = (const float*)ap_->in[17]; P.dsk = (const float*)ap_->in[18]; \
    P.w_glu = (const float*)ap_->in[19]; P.w_out = (const float*)ap_->in[20]; P.w_ff1 = (const float*)ap_->in[21]; P.w_ff2 = (const float*)ap_->in[22]; \
    P.out = ap_->out; \
    P.MODP = (float*)(ws + WS_MODP); P.MOD = (float*)(ws + WS_MOD); P.ROPE = (float*)(ws + WS_ROPE); P.F = (float*)(ws + WS_F); P.U = (bf16*)(ws + WS_U); P.BIAS2 = (float*)(ws + WS_BIAS2); P.SSQ = (float*)(ws + WS_SSQ); \
    P.H8 = ws + WS_H8; P.WG8 = ws + WS_WG8; P.WINU = (bf16*)(ws + WS_WINU); P.HI8 = ws + WS_HI8; P.MRGI8 = ws + WS_MRGI8; P.MMAX = (float*)(ws + WS_MMAX); P.SAH = (float*)(ws + WS_SAH); P.SAM = (float*)(ws + WS_SAM); P.WMAXU = (unsigned*)(ws + WS_WMAXU); P.WMAXO = (unsigned*)(ws + WS_WMAXO); P.WIN = (bf16*)(ws + WS_WIN); P.WGLU = (bf16*)(ws + WS_WGLU); P.WOUT = (bf16*)(ws + WS_WOUT); P.WFF1 = (bf16*)(ws + WS_WFF1); P.WFF2 = (bf16*)(ws + WS_WFF2); \
    P.H = (bf16*)(ws + WS_H); P.Q = (bf16*)(ws + WS_Q); P.K = (bf16*)(ws + WS_K); P.V = (bf16*)(ws + WS_V); P.GA = (unsigned char*)(ws + WS_GA); P.GS = (unsigned char*)(ws + WS_GS); \
    P.ATT = (bf16*)(ws + WS_ATT); P.YG = (bf16*)(ws + WS_YG); P.MRG = ws + WS_MRG; P.FFH = (bf16*)(ws + WS_FFH); (void)ws

    for (int u = threadIdx.x; u < (LDS_BYTES - MISC_OFF) / 4; u += NTHR) MISC[u] = 0u;
    __syncthreads();
    XcdBarrier bar; { gu32* ctl = (gu32*)(args.ws + WS_CTL); bar = xcd_barrier_post((unsigned*)(ctl + CW_BAR), MISC + 8); }

    { MAKE_PTRS(); FRESH_IDS(); phase0(P, lds, bx, G, tid, wave, lane); }
    xcd_barrier(bar);
    { MAKE_PTRS(); FRESH_IDS(); phase1(P, lds, bx, G, tid, wave, lane); }
    xcd_barrier(bar);
    {
        MAKE_PTRS();
        pg8::Gemm g{(const bf16*)P.H8, (const bf16*)P.WG8, SEQ, 14336, DM / 2}; pg8::StaticOrder S; S.init(SEQ, 14336, G, bx);
        pg8::EpiProj E{P.Q, P.K, P.V, P.GA, P.GS, P.qng, P.kng, P.ROPE, (PG8_LAS float*)(lds + XCH_OFF)};
        pg8::gemm_phase<pg8::EpiProj, pg8::StaticOrder, true, true, true>(lds, g, S, E, bar.wave);
    }
    {
        MAKE_PTRS();
        pg8::Gemm g{(const bf16*)P.HI8, P.WINU, SEQ, 2048, DM / 2}; pg8::StaticOrder S; S.init(SEQ, 2048, G, bx);
        pg8::EpiU E{P.U, P.SAH, P.WMAXU};
        pg8::gemm_phase<pg8::EpiU, pg8::StaticOrder, true, true, false, true>(lds, g, S, E, bar.wave);
    }
    xcd_barrier(bar);
    constexpr int TI_P3 = 18432;
    {
        MAKE_PTRS(); FRESH_IDS();
        for (int u = bx; u < 64 * NKVH; u += G) attn_unit(P, u >> 3, u & 7, lds, tid, wave, lane);
        if (wave < 4) { const int gw4 = bx * 4 + wave, NGW4 = G * 4;
            for (int id = gw4; id < SSM_NSC * NGRP; id += NGW4) ssm_unit<false>(P, id >> 7, id & 127, lds + wave * SSM_WL, lane); }
        const int per = (TI_P3 + G - 1) / G, lo = bx * per, hi = (lo + per < TI_P3) ? lo + per : TI_P3;
        transpose_pool<1>(P, lo, hi, (LAS unsigned*)(lds + MISC_OFF) + 16, (LAS float*)(lds + wave * SSM_WL), lane);
    }
    xcd_barrier(bar);
    {
        MAKE_PTRS(); FRESH_IDS();
        if (wave < 4) { const int gw4 = bx * 4 + wave, NGW4 = G * 4;
            for (int id = gw4; id < SSM_NSC * NGRP; id += NGW4) ssm_unit<true>(P, id >> 7, id & 127, lds + wave * SSM_WL, lane); }
        const int per = (TI_ALL - TI_P3 + G - 1) / G, lo = TI_P3 + bx * per, hi = (lo + per < TI_ALL) ? lo + per : TI_ALL;
        transpose_pool<1>(P, lo, hi, (LAS unsigned*)(lds + MISC_OFF) + 17, (LAS float*)(lds + wave * SSM_WL), lane);
    }
    xcd_barrier(bar);
    {
        MAKE_PTRS();
        pg8::Gemm g{P.YG, P.WGLU, SEQ, 2 * DM, SSMW / 2}; pg8::StaticOrder S; S.init(SEQ, 2 * DM, G, bx);
        pg8::EpiGlu E{P.GS, P.ATT, P.MRG, P.MMAX};
        pg8::gemm_phase<pg8::EpiGlu, pg8::StaticOrder, true, true, true>(lds, g, S, E, bar.wave);
    }
    xcd_barrier(bar);
    {
        MAKE_PTRS(); FRESH_IDS();
        const int gw = bx * NWAVES + wave, NGW = G * NWAVES;
        for (int row = gw; row < SEQ; row += NGW) quant_row(P.MRG + (size_t)row * DM, P.MMAX + (size_t)row * 128, P.MRGI8 + (size_t)row * DM, P.SAM + row, lane);
    }
    xcd_barrier(bar);
    {
        MAKE_PTRS();
        pg8::Gemm g{(const bf16*)P.MRGI8, P.WOUT, SEQ, DM, DM / 2}; pg8::StaticOrder S; S.init(SEQ, DM, G, bx);
        pg8::EpiResid<true> E{P.x, nullptr, nullptr, P.MOD + 2 * DM, P.H, P.SSQ, P.SAM, P.WMAXO};
        pg8::gemm_phase<pg8::EpiResid<true>, pg8::StaticOrder, true, true, false, true>(lds, g, S, E, bar.wave);
    }
    xcd_barrier(bar);
    {
        MAKE_PTRS();
        pg8::Gemm g{P.H, P.WFF1, SEQ, DFF, DM}; pg8::StaticOrder S; S.init(SEQ, DFF, G, bx);
        LAS float* rst = (LAS float*)(lds + XCH_OFF);
        { pg8::Unit u0, ui; S.next(0, u0); bool same = true; for (int i = 1; S.next(i, ui); ++i) same = same && (ui.pm == u0.pm);
          FRESH_IDS(); const int t = tid;
          if (t < 256) { const f32x4* sp = (const f32x4*)(P.SSQ + (size_t)(u0.pm * 256 + t) * 64); f32x4 a = {0.f, 0.f, 0.f, 0.f};
#pragma unroll
              for (int q = 0; q < 16; ++q) a += sp[q];
              const float s = (a[0] + a[1]) + (a[2] + a[3]);
              rst[t] = same ? 1.0f / sqrtf(s * (1.0f / DM) + EPS) : __builtin_nanf(""); }
          __syncthreads(); }
        pg8::EpiRelu2<true> E{P.FFH, DFF, rst, P.BIAS2};
        pg8::gemm_phase<pg8::EpiRelu2<true>, pg8::StaticOrder, true, true>(lds, g, S, E, bar.wave);
    }
    xcd_barrier(bar);
    {
        MAKE_PTRS();
        pg8::Gemm g{P.FFH, P.WFF2, SEQ, DM, DFF}; pg8::StaticOrder S; S.init(SEQ, DM, G, bx);
        pg8::EpiResid<false> E{nullptr, P.H, P.out, P.MOD + 5 * DM, nullptr, nullptr, nullptr, nullptr};
        pg8::gemm_phase<pg8::EpiResid<false>, pg8::StaticOrder, true, true>(lds, g, S, E, bar.wave);
    }
}

extern "C" void kernel_launch(void* const* d_in, const int* in_sizes, int n_in, void* d_out, int out_size, void* d_ws, size_t ws_size, hipStream_t stream) {
    static int grid = 0;
    if (grid == 0) {
        if (n_in != 23 || in_sizes[0] != SEQ * DM || out_size != SEQ * DM || ws_size < WS_END) {
            fprintf(stderr, "kernel_launch: unexpected problem (n_in %d, in0 %d, out %d, ws %zu); nothing launched\n", n_in, n_in > 0 ? in_sizes[0] : -1, out_size, ws_size); grid = -1; return; }
        int dev = 0, cus = 0, per_cu = 0;
        if (hipGetDevice(&dev) != hipSuccess || hipDeviceGetAttribute(&cus, hipDeviceAttributeMultiprocessorCount, dev) != hipSuccess) { fprintf(stderr, "kernel_launch: device query failed\n"); grid = -1; return; }
        if (hipFuncSetAttribute((const void*)mk_fwd, hipFuncAttributeMaxDynamicSharedMemorySize, LDS_BYTES) != hipSuccess) { fprintf(stderr, "kernel_launch: hipFuncSetAttribute failed\n"); grid = -1; return; }
        if (hipOccupancyMaxActiveBlocksPerMultiprocessor(&per_cu, (const void*)mk_fwd, NTHR, LDS_BYTES) != hipSuccess || per_cu < 1)
            fprintf(stderr, "kernel_launch: note: occupancy query reports %d workgroups per CU\n", per_cu);
        (void)hipGetLastError();
        if (cus != 256) { fprintf(stderr, "kernel_launch: built for a 256-CU device (got %d CUs); nothing launched\n", cus); grid = -1; return; }
        grid = cus;
    }
    if (grid < 0) return;
    if (hipMemsetAsync((char*)d_ws + WS_CTL, 0, CTL_ZERO_BYTES, stream) != hipSuccess) { fprintf(stderr, "kernel_launch: memset failed\n"); return; }
    Args a{};
    for (int i = 0; i < 23; ++i) a.in[i] = d_in[i];
    a.out = (float*)d_out; a.ws = (unsigned char*)d_ws;
    hipLaunchKernelGGL(mk_fwd, dim3(grid), dim3(NTHR), LDS_BYTES, stream, a);
    const hipError_t le = hipPeekAtLastError();
    if (le != hipSuccess) fprintf(stderr, "kernel_launch: launch failed: %s\n", hipGetErrorName(le));
}
```

```cpp
#include <hip/hip_runtime.h>
#include <cstdio>
#include <cstdint>
namespace pg8 {
#define PG8_LAS __attribute__((address_space(3)))
typedef unsigned short bf16_t;
typedef short bf16x8 __attribute__((ext_vector_type(8)));
typedef float f32x4 __attribute__((ext_vector_type(4)));
typedef unsigned u32x4 __attribute__((ext_vector_type(4)));
typedef unsigned u32x2 __attribute__((ext_vector_type(2)));
typedef int i32x4 __attribute__((ext_vector_type(4)));
typedef int i32x8 __attribute__((ext_vector_type(8)));
constexpr int BM = 256, BK = 64, HALF = 128, HTB = HALF * BK * 2  , STAGE_BYTES = 8 * HTB, NXCD = 8, WGM = 8;

__host__ __device__ __forceinline__ int lds_byte(int r, int c) { const int st = (r >> 4) * 2 + (c >> 5), rr = r & 15, cc = c & 31, ob = rr * 64 + cc * 2; return st * 1024 + (ob ^ (((ob >> 9) & 1) << 5)); }
__host__ __device__ __forceinline__ void stage_rc(int b, int& R, int& C) { const int st = b / 1024, sb = b % 1024, swz = sb ^ (((sb >> 9) & 1) << 5); R = (st >> 1) * 16 + swz / 64; C = (st & 1) * 32 + (swz % 64) / 2; }
__host__ __device__ __forceinline__ int f8swz(int r) { return ((r >> 1) & 1) | (((r >> 3) & 1) << 2); }
__host__ __device__ __forceinline__ int lds_byte8(int r, int c) { return (r >> 4) * 2048 + (r & 15) * 128 + ((c ^ f8swz(r & 15)) << 4); }
__host__ __device__ __forceinline__ void stage_rc8(int b, int& R, int& Cb) { const int grp = b >> 11, r = (b >> 7) & 15, slot = (b >> 4) & 7; R = grp * 16 + r; Cb = (slot ^ f8swz(r)) << 4; }
__host__ __device__ __forceinline__ int perm32(int rho) { const int n = rho >> 4, i = rho & 15; return 8 * (i >> 2) + 4 * n + (i & 3); }

struct Unit { int pm, pn; };
struct Gemm { const bf16_t* A; const bf16_t* Bt; int M, N, K; };

struct StaticOrder {
    int nM, nN, nwg, G, c;
    __host__ __device__ __forceinline__ void init(int M, int N, int G_, int c_) { nM = M / BM; nN = N / BM; nwg = nM * nN; G = G_; c = c_; }
    __host__ __device__ __forceinline__ bool next(int i, Unit& u) const {
        const long L = (long)i * G + c; if (L >= nwg) return false;
        int wgid = (int)L; { const int q = nwg / NXCD, r = nwg % NXCD, xcd = wgid % NXCD, off = wgid / NXCD; wgid = (xcd < r ? xcd * (q + 1) : r * (q + 1) + (xcd - r) * q) + off; }
        const int nig = WGM * nN, gid = wgid / nig, fm = gid * WGM, gsz = (nM - fm) < WGM ? (nM - fm) : WGM;
        u.pm = fm + ((wgid % nig) % gsz); u.pn = (wgid % nig) / gsz; return true;
    }
    __device__ __forceinline__ void a_ready(const Unit&) const {}
    __device__ __forceinline__ void done(const Unit&) const {}
};


typedef float f32x2 __attribute__((ext_vector_type(2)));
typedef __bf16 bf16x2_t __attribute__((ext_vector_type(2)));
__device__ __forceinline__ unsigned cvt_pk_bf16(float lo, float hi) { f32x2 v = {lo, hi}; bf16x2_t b = __builtin_convertvector(v, bf16x2_t); return __builtin_bit_cast(unsigned, b); }
__device__ __forceinline__ float bf_lo(unsigned w) { return __uint_as_float(w << 16); }
__device__ __forceinline__ float bf_hi(unsigned w) { return __uint_as_float(w & 0xffff0000u); }
__device__ __forceinline__ unsigned pk4_i8(float a, float b, float c, float d) {
    const int ia = (int)__builtin_rintf(fminf(fmaxf(a, -127.f), 127.f)), ib = (int)__builtin_rintf(fminf(fmaxf(b, -127.f), 127.f)), ic = (int)__builtin_rintf(fminf(fmaxf(c, -127.f), 127.f)), id = (int)__builtin_rintf(fminf(fmaxf(d, -127.f), 127.f));
    return (unsigned)(ia & 255) | ((unsigned)(ib & 255) << 8) | ((unsigned)(ic & 255) << 16) | ((unsigned)(id & 255) << 24);
}
__device__ __forceinline__ unsigned pk4_u8(float a, float b, float c, float d) {
    const unsigned ua = (unsigned)(a * 255.0f + 0.5f), ub = (unsigned)(b * 255.0f + 0.5f), uc = (unsigned)(c * 255.0f + 0.5f), ud = (unsigned)(d * 255.0f + 0.5f);
    return ua | (ub << 8) | (uc << 16) | (ud << 24); }
__device__ __forceinline__ float u8f(unsigned w, int i) { return (float)((w >> (8 * i)) & 0xffu); }
__device__ __forceinline__ float sigmoidf_fast(float x) { return __builtin_amdgcn_rcpf(1.0f + __builtin_amdgcn_exp2f(-1.4426950408889634f * x)); }

__device__ __forceinline__ unsigned pk4_fp8(float a, float b, float c, float d) {
    a = fminf(fmaxf(a, -448.f), 448.f); b = fminf(fmaxf(b, -448.f), 448.f); c = fminf(fmaxf(c, -448.f), 448.f); d = fminf(fmaxf(d, -448.f), 448.f);
    int w = 0; w = __builtin_amdgcn_cvt_pk_fp8_f32(a, b, w, false); w = __builtin_amdgcn_cvt_pk_fp8_f32(c, d, w, true); return (unsigned)w;
}
constexpr float W8_SCALE = 128.0f;
constexpr float QSCALE = 0.08838834764831845f * 1.4426950408889634f;

struct EpiProj {
    static constexpr bool PERM = false, AFTER_DRAIN = false;
    bf16_t *Q, *K, *V; unsigned char *GA, *GS;     const float *qg, *kg, *rope; PG8_LAS float* xch;
    __device__ __forceinline__ void operator()(f32x4 (&acc)[2][2][4][2], const Unit& u, int wr, int wc, int fr, int fq) const {
        constexpr float DS = 1.0f / W8_SCALE;
        const int row0 = u.pm * BM + wr * 64 + fr; const int pn = u.pn;
        if (pn < 20) {
            const bool isq = pn < 16; const int head0 = isq ? 2 * pn : 2 * (pn - 16); bf16_t* dst = isq ? Q : K; const int ld = isq ? 4096 : 1024;
            const float* gain = isq ? qg : kg; const float osc = isq ? QSCALE : 1.0f;
#pragma unroll
            for (int ai = 0; ai < 2; ++ai)
#pragma unroll
                for (int m = 0; m < 4; ++m)
#pragma unroll
                    for (int bj = 0; bj < 2; ++bj) {
                        const f32x4 a0 = acc[ai][bj][m][0] * DS, a1 = acc[ai][bj][m][1] * DS;
                        float ss = (a0[0] * a0[0] + a0[1] * a0[1]) + (a0[2] * a0[2] + a0[3] * a0[3]) + (a1[0] * a1[0] + a1[1] * a1[1]) + (a1[2] * a1[2] + a1[3] * a1[3]);
                        ss += __shfl_xor(ss, 16); ss += __shfl_xor(ss, 32);
                        if (fq == 0) xch[((ai * HALF + wr * 64 + m * 16 + fr) * 2 + bj) * 4 + wc] = ss;
                    }
            asm volatile("s_waitcnt lgkmcnt(0)" ::: "memory"); __builtin_amdgcn_s_barrier(); asm volatile("" ::: "memory");
            f32x4 gv[2];
#pragma unroll
            for (int n = 0; n < 2; ++n) gv[n] = *(const f32x4*)(gain + 32 * wc + 16 * n + 4 * fq);
#pragma unroll
            for (int ai = 0; ai < 2; ++ai) {
                f32x4 csv[4], snv[4];
                if (wc == 0) {
#pragma unroll
                    for (int m = 0; m < 4; ++m) { const size_t row = (size_t)(u.pm * BM + ai * HALF + wr * 64 + m * 16 + fr);
                        csv[m] = *(const f32x4*)(rope + row * 32 + 4 * fq); snv[m] = *(const f32x4*)(rope + row * 32 + 16 + 4 * fq); }
                }
#pragma unroll
                for (int m = 0; m < 4; ++m) {
                    const int rl = ai * HALF + wr * 64 + m * 16 + fr; const size_t row = (size_t)(u.pm * BM + rl);
                    f32x4 cs = {1.f, 1.f, 1.f, 1.f}, sn = {0.f, 0.f, 0.f, 0.f};
                    if (wc == 0) { cs = csv[m]; sn = snv[m]; }
#pragma unroll
                    for (int bj = 0; bj < 2; ++bj) {
                        const f32x4 t = *(const PG8_LAS f32x4*)(xch + (rl * 2 + bj) * 4);
                        const float tot = (t[0] + t[1]) + (t[2] + t[3]);
                        const float rstd = 1.0f / sqrtf(tot * (1.0f / 128.0f) + 1e-6f);
                        f32x4 y0 = acc[ai][bj][m][0] * (DS * rstd) * gv[0], y1 = acc[ai][bj][m][1] * (DS * rstd) * gv[1];
                        if (wc == 0) { const f32x4 r0 = y0 * cs - y1 * sn, r1 = y1 * cs + y0 * sn; y0 = r0; y1 = r1; }
                        y0 = y0 * osc; y1 = y1 * osc;
                        u32x4 w; w.x = cvt_pk_bf16(y0[0], y0[1]); w.y = cvt_pk_bf16(y0[2], y0[3]); w.z = cvt_pk_bf16(y1[0], y1[1]); w.w = cvt_pk_bf16(y1[2], y1[3]);
                        *(u32x4*)(dst + row * ld + (head0 + bj) * 128 + 32 * wc + 8 * fq) = w;
                    }
                }
                asm volatile("" ::: "memory");
            }
        } else if (pn < 24) {
            const int col0 = (pn - 20) * BM + wc * 32 + 8 * fq;
#pragma unroll
            for (int ai = 0; ai < 2; ++ai)
#pragma unroll
                for (int m = 0; m < 4; ++m) { bf16_t* rowp = V + (size_t)(row0 + ai * HALF + m * 16) * 1024 + col0;
#pragma unroll
                    for (int bj = 0; bj < 2; ++bj) { const f32x4 v0 = acc[ai][bj][m][0] * DS, v1 = acc[ai][bj][m][1] * DS;
                        u32x4 w; w.x = cvt_pk_bf16(v0[0], v0[1]); w.y = cvt_pk_bf16(v0[2], v0[3]); w.z = cvt_pk_bf16(v1[0], v1[1]); w.w = cvt_pk_bf16(v1[2], v1[3]);
                        *(u32x4*)(rowp + bj * HALF) = w; } }
        } else {
            unsigned char* dst = pn < 40 ? GA : GS; const int col0 = ((pn - 24) & 15) * BM + wc * 32 + 8 * fq;
#pragma unroll
            for (int ai = 0; ai < 2; ++ai)
#pragma unroll
                for (int m = 0; m < 4; ++m) { unsigned char* rowp = dst + (size_t)(row0 + ai * HALF + m * 16) * 4096 + col0;
#pragma unroll
                    for (int bj = 0; bj < 2; ++bj) { f32x4 v0 = acc[ai][bj][m][0] * DS, v1 = acc[ai][bj][m][1] * DS;
#pragma unroll
                        for (int j = 0; j < 4; ++j) { v0[j] = sigmoidf_fast(v0[j]); v1[j] = sigmoidf_fast(v1[j]); }
                        u32x2 w; w.x = pk4_u8(v0[0], v0[1], v0[2], v0[3]); w.y = pk4_u8(v1[0], v1[1], v1[2], v1[3]);
                        *(u32x2*)(rowp + bj * HALF) = w; } }
        }
    }
};

__device__ __forceinline__ f32x4 i32_to_f32(const f32x4 a) { const i32x4 v = __builtin_bit_cast(i32x4, a); return (f32x4){(float)v[0], (float)v[1], (float)v[2], (float)v[3]}; }
struct EpiU {
    static constexpr bool PERM = false, AFTER_DRAIN = false;
    bf16_t* U; const float* sa; const unsigned* wmax;
    __device__ __forceinline__ void operator()(const f32x4 (&acc)[2][2][4][2], const Unit& u, int wr, int wc, int fr, int fq) const {
        const int row0 = u.pm * BM + wr * 64 + fr, col0 = u.pn * BM + wc * 32 + 8 * fq;
        f32x4 sw[2][2];
#pragma unroll
        for (int bj = 0; bj < 2; ++bj)
#pragma unroll
            for (int n = 0; n < 2; ++n) { const u32x4 w = *(const u32x4*)(wmax + col0 + bj * HALF + 4 * n);
                sw[bj][n] = (f32x4){__uint_as_float(w.x), __uint_as_float(w.y), __uint_as_float(w.z), __uint_as_float(w.w)} * (1.0f / 127.0f); }
#pragma unroll
        for (int ai = 0; ai < 2; ++ai)
#pragma unroll
            for (int m = 0; m < 4; ++m) { const int row = row0 + ai * HALF + m * 16; bf16_t* rowp = U + (size_t)row * 2048 + col0; const float s = sa[row];
#pragma unroll
                for (int bj = 0; bj < 2; ++bj) { const f32x4 v0 = i32_to_f32(acc[ai][bj][m][0]) * (sw[bj][0] * s), v1 = i32_to_f32(acc[ai][bj][m][1]) * (sw[bj][1] * s);
                    u32x4 w; w.x = cvt_pk_bf16(v0[0], v0[1]); w.y = cvt_pk_bf16(v0[2], v0[3]); w.z = cvt_pk_bf16(v1[0], v1[1]); w.w = cvt_pk_bf16(v1[2], v1[3]);
                    *(u32x4*)(rowp + bj * HALF) = w; } }
    }
};

struct EpiGlu {
    static constexpr bool PERM = false, AFTER_DRAIN = false;
    const unsigned char* GS; const bf16_t* ATT; unsigned char* MRG; float* mmax;
    __device__ __forceinline__ void operator()(const f32x4 (&acc)[2][2][4][2], const Unit& u, int wr, int wc, int fr, int fq) const {
        const int row0 = u.pm * BM + wr * 64 + fr; const int ch0 = u.pn * 128 + wc * 32 + 8 * fq;
        constexpr float DS = 1.0f / W8_SCALE;
        u32x2 gs[2][4]; u32x4 at[2][4];
#pragma unroll
        for (int ai = 0; ai < 2; ++ai)
#pragma unroll
            for (int m = 0; m < 4; ++m) { const size_t off = (size_t)(row0 + ai * HALF + m * 16) * 4096 + ch0; gs[ai][m] = *(const u32x2*)(GS + off); at[ai][m] = *(const u32x4*)(ATT + off); }
#pragma unroll
        for (int ai = 0; ai < 2; ++ai) {
#pragma unroll
            for (int m = 0; m < 4; ++m) {
                const size_t off = (size_t)(row0 + ai * HALF + m * 16) * 4096 + ch0;
                float mv[8]; float am = 0.f;
#pragma unroll
                for (int q = 0; q < 4; ++q) {
                    const int n = q >> 1, j = 2 * (q & 1);
                    const float v0 = acc[ai][0][m][n][j] * DS, v1 = acc[ai][0][m][n][j + 1] * DS, g0 = acc[ai][1][m][n][j] * DS, g1 = acc[ai][1][m][n][j + 1] * DS;
                    const float s0 = v0 * sigmoidf_fast(g0), s1 = v1 * sigmoidf_fast(g1);
                    const float m0 = bf_lo(at[ai][m][q]) + u8f(gs[ai][m][n], j) * (s0 * (1.0f / 255.0f)), m1 = bf_hi(at[ai][m][q]) + u8f(gs[ai][m][n], j + 1) * (s1 * (1.0f / 255.0f));
                    am = fmaxf(am, fmaxf(fabsf(m0), fabsf(m1)));
                    mv[2 * q] = m0; mv[2 * q + 1] = m1;
                }
                am = fmaxf(am, __shfl_xor(am, 16)); am = fmaxf(am, __shfl_xor(am, 32));
                const float iq = am > 0.f ? 127.0f * __builtin_amdgcn_rcpf(am) : 0.f;
                u32x2 w; w.x = pk4_i8(mv[0] * iq, mv[1] * iq, mv[2] * iq, mv[3] * iq); w.y = pk4_i8(mv[4] * iq, mv[5] * iq, mv[6] * iq, mv[7] * iq);
                *(u32x2*)(MRG + off) = w;
                if (fq == 0) mmax[(size_t)(row0 + ai * HALF + m * 16) * 128 + 4 * u.pn + wc] = am;
            }
        }
    }
};

template <bool NORM> struct EpiResid {
    static constexpr bool PERM = false, AFTER_DRAIN = false;
    const float* xin; const bf16_t* x1b_in; float* out; const float* gate; bf16_t* x1b_out; float* ssq; const float* sa; const unsigned* wmax;
    __device__ __forceinline__ void operator()(const f32x4 (&acc)[2][2][4][2], const Unit& u, int wr, int wc, int fr, int fq) const {
        const int row0 = u.pm * BM + wr * 64 + fr, col0 = u.pn * BM + wc * 32 + 8 * fq;
        f32x4 gv[2][2];
#pragma unroll
        for (int bj = 0; bj < 2; ++bj)
#pragma unroll
            for (int n = 0; n < 2; ++n) gv[bj][n] = *(const f32x4*)(gate + col0 + bj * HALF + 4 * n);
        if constexpr (NORM) {
#pragma unroll
            for (int bj = 0; bj < 2; ++bj)
#pragma unroll
                for (int n = 0; n < 2; ++n) { const u32x4 w = *(const u32x4*)(wmax + col0 + bj * HALF + 4 * n);
                    gv[bj][n] = gv[bj][n] * (f32x4){__uint_as_float(w.x), __uint_as_float(w.y), __uint_as_float(w.z), __uint_as_float(w.w)} * (1.0f / 127.0f); }
#pragma unroll
            for (int ai = 0; ai < 2; ++ai) {
                f32x4 bs[4][2][2];
#pragma unroll
                for (int m = 0; m < 4; ++m) { const size_t off = (size_t)(row0 + ai * HALF + m * 16) * 4096 + col0;
#pragma unroll
                    for (int bj = 0; bj < 2; ++bj)
#pragma unroll
                        for (int n = 0; n < 2; ++n) bs[m][bj][n] = *(const f32x4*)(xin + off + bj * HALF + 4 * n); }
#pragma unroll
                for (int m = 0; m < 4; ++m) { const int row = row0 + ai * HALF + m * 16; const size_t off = (size_t)row * 4096 + col0; float ss = 0.f; const float rs = sa[row];
#pragma unroll
                    for (int bj = 0; bj < 2; ++bj) { const f32x4 o0 = bs[m][bj][0] + gv[bj][0] * (i32_to_f32(acc[ai][bj][m][0]) * rs), o1 = bs[m][bj][1] + gv[bj][1] * (i32_to_f32(acc[ai][bj][m][1]) * rs);
                        ss += (o0[0] * o0[0] + o0[1] * o0[1]) + (o0[2] * o0[2] + o0[3] * o0[3]) + (o1[0] * o1[0] + o1[1] * o1[1]) + (o1[2] * o1[2] + o1[3] * o1[3]);
                        u32x4 w; w.x = cvt_pk_bf16(o0[0], o0[1]); w.y = cvt_pk_bf16(o0[2], o0[3]); w.z = cvt_pk_bf16(o1[0], o1[1]); w.w = cvt_pk_bf16(o1[2], o1[3]);
                        *(u32x4*)(x1b_out + off + bj * HALF) = w; }
                    ss += __shfl_xor(ss, 16); ss += __shfl_xor(ss, 32); if (fq == 0) ssq[(size_t)row * 64 + 4 * u.pn + wc] = ss; }
                asm volatile("" ::: "memory");
            }
        } else {
#pragma unroll
            for (int ai = 0; ai < 2; ++ai) {
                u32x4 bs[4][2];
#pragma unroll
                for (int m = 0; m < 4; ++m) { const size_t off = (size_t)(row0 + ai * HALF + m * 16) * 4096 + col0;
#pragma unroll
                    for (int bj = 0; bj < 2; ++bj) bs[m][bj] = *(const u32x4*)(x1b_in + off + bj * HALF); }
#pragma unroll
                for (int m = 0; m < 4; ++m) { const size_t off = (size_t)(row0 + ai * HALF + m * 16) * 4096 + col0;
#pragma unroll
                    for (int bj = 0; bj < 2; ++bj) { const u32x4 b = bs[m][bj];
                        const f32x4 x0 = {bf_lo(b.x), bf_hi(b.x), bf_lo(b.y), bf_hi(b.y)}, x1 = {bf_lo(b.z), bf_hi(b.z), bf_lo(b.w), bf_hi(b.w)};
                        *(f32x4*)(out + off + bj * HALF) = x0 + gv[bj][0] * acc[ai][bj][m][0]; *(f32x4*)(out + off + bj * HALF + 4) = x1 + gv[bj][1] * acc[ai][bj][m][1]; } }
                asm volatile("" ::: "memory");
            }
        }
    }
};

template <bool NORM> struct EpiRelu2 {
    static constexpr bool PERM = false, AFTER_DRAIN = false;
    bf16_t* O; int ldc; const PG8_LAS float* rstd; const float* bias;
    __device__ __forceinline__ void operator()(const f32x4 (&acc)[2][2][4][2], const Unit& u, int wr, int wc, int fr, int fq) const {
        const int row0 = u.pm * BM + wr * 64 + fr, col0 = u.pn * BM + wc * 32 + 8 * fq;
        f32x4 bv[2][2];
#pragma unroll
        for (int bj = 0; bj < 2; ++bj)
#pragma unroll
            for (int n = 0; n < 2; ++n) bv[bj][n] = NORM ? *(const f32x4*)(bias + col0 + bj * HALF + 4 * n) : (f32x4){0.f, 0.f, 0.f, 0.f};
#pragma unroll
        for (int ai = 0; ai < 2; ++ai)
#pragma unroll
            for (int m = 0; m < 4; ++m) { bf16_t* rowp = O + (size_t)(row0 + ai * HALF + m * 16) * ldc + col0;
                const float rs = NORM ? rstd[ai * HALF + wr * 64 + m * 16 + fr] : 1.0f;
#pragma unroll
                for (int bj = 0; bj < 2; ++bj) { f32x4 v0 = acc[ai][bj][m][0], v1 = acc[ai][bj][m][1];
                    if (NORM) { v0 = v0 * rs + bv[bj][0]; v1 = v1 * rs + bv[bj][1]; }
#pragma unroll
                    for (int j = 0; j < 4; ++j) { const float a = fmaxf(v0[j], 0.f), b = fmaxf(v1[j], 0.f); v0[j] = a * a; v1[j] = b * b; }
                    u32x4 w; w.x = cvt_pk_bf16(v0[0], v0[1]); w.y = cvt_pk_bf16(v0[2], v0[3]); w.z = cvt_pk_bf16(v1[0], v1[1]); w.w = cvt_pk_bf16(v1[2], v1[3]);
                    *(u32x4*)(rowp + bj * HALF) = w; } }
    }
};
template <class Epi, class Sched, bool ALIGN_EPI = false, bool SP2 = false, bool FP8 = false, bool I8 = false, bool SP4 = false>
__device__ __forceinline__ void gemm_phase(PG8_LAS unsigned char* lds, const Gemm g, const Sched& S, const Epi& E, const int wave_id  ) {
    int tid_ = wave_id * 64 + (int)__builtin_amdgcn_mbcnt_hi(~0u, __builtin_amdgcn_mbcnt_lo(~0u, 0u)); asm volatile("" : "+v"(tid_));
    const int tid = tid_, wid = __builtin_amdgcn_readfirstlane(tid >> 6), lane = tid & 63, wr = wid >> 2, wc = wid & 3, fr = lane & 15, fq = lane >> 4;
    const int K = g.K, nt = K / BK;
    unsigned voffA[2], voffB[2];
#pragma unroll
    for (int i = 0; i < 2; ++i) {
        if constexpr (FP8) { int R, Cb; stage_rc8(tid * 16 + i * 8192, R, Cb); voffA[i] = (unsigned)(R * K) * 2u + (unsigned)Cb; voffB[i] = voffA[i]; }
        else { int R, C; stage_rc(tid * 16 + i * 8192, R, C); const int Rb = Epi::PERM ? ((R & ~31) + perm32(R & 31)) : R;
            voffA[i] = (unsigned)(R * K + C) * 2u; voffB[i] = (unsigned)(Rb * K + C) * 2u; } }
    const size_t r64step = (size_t)64 * K * 2;
    const size_t kstep = (size_t)(BK * 2);
    const size_t hstep = (size_t)HALF * K * 2;
    const size_t tstep = 2 * hstep;
    const unsigned ldsw = (unsigned)wid * 1024u;
    const int aoff = lds_byte(wr * 64 + fr, fq * 8), boff = lds_byte(wc * 32 + fr, fq * 8);
    const int aoff8 = lds_byte8(wr * 64 + fr, 2 * fq), aoff8b = lds_byte8(wr * 64 + fr, 2 * fq + 1), boff8 = lds_byte8(wc * 32 + fr, 2 * fq), boff8b = lds_byte8(wc * 32 + fr, 2 * fq + 1);
#define PG8_SA(b, h) (((b) * 2 + (h)) * HTB)
#define PG8_SB(b, h) ((4 + (b) * 2 + (h)) * HTB)
    unsigned ldsw_s = __builtin_amdgcn_readfirstlane((unsigned)(__SIZE_TYPE__)lds + ldsw); asm volatile("" : "+s"(ldsw_s));
#define PG8_DMA(v_, b_, imm_) asm volatile("s_add_i32 m0, %2, %3\n\ts_nop 0\n\tglobal_load_lds_dwordx4 %0, %1" :: "v"(v_), "s"(b_), "s"(ldsw_s), "n"(imm_) : "memory", "scc")
#define PG8_STAGE(bufoff, gbase, voff) do { const char* gb_ = (const char*)(gbase); PG8_DMA((voff)[0], gb_, (bufoff)); PG8_DMA((voff)[1], gb_, (bufoff) + 8192); } while (0)
#define PG8_LDA(dst, b, h) do { _Pragma("unroll") for (int m = 0; m < 4; ++m) _Pragma("unroll") for (int k = 0; k < 2; ++k) dst[m][k] = *(const PG8_LAS bf16x8*)(lds + PG8_SA(b, h) + aoff + m * 2048 + k * 1024); } while (0)
#define PG8_LDB(dst, b, h) do { _Pragma("unroll") for (int n = 0; n < 2; ++n) _Pragma("unroll") for (int k = 0; k < 2; ++k) dst[n][k] = *(const PG8_LAS bf16x8*)(lds + PG8_SB(b, h) + boff + n * 2048 + k * 1024); } while (0)
#define PG8_MMA(ai, bj, At, Bt) do { __builtin_amdgcn_s_setprio(1); _Pragma("unroll") for (int m = 0; m < 4; ++m) _Pragma("unroll") for (int n = 0; n < 2; ++n) _Pragma("unroll") for (int k = 0; k < 2; ++k) \
        acc[ai][bj][m][n] = __builtin_amdgcn_mfma_f32_16x16x32_bf16(Bt[n][k], At[m][k], acc[ai][bj][m][n], 0, 0, 0); __builtin_amdgcn_s_setprio(0); } while (0)
#define PG8_LDA8(dst, b, h) do { _Pragma("unroll") for (int m = 0; m < 4; ++m) { const PG8_LAS unsigned char* p_ = lds + PG8_SA(b, h) + aoff8 + m * 2048; \
        dst[m] = __builtin_shufflevector(*(const PG8_LAS i32x4*)p_, *(const PG8_LAS i32x4*)(lds + PG8_SA(b, h) + aoff8b + m * 2048), 0, 1, 2, 3, 4, 5, 6, 7); } } while (0)
#define PG8_LDB8(dst, b, h) do { _Pragma("unroll") for (int n = 0; n < 2; ++n) { const PG8_LAS unsigned char* p_ = lds + PG8_SB(b, h) + boff8 + n * 2048; \
        dst[n] = __builtin_shufflevector(*(const PG8_LAS i32x4*)p_, *(const PG8_LAS i32x4*)(lds + PG8_SB(b, h) + boff8b + n * 2048), 0, 1, 2, 3, 4, 5, 6, 7); } } while (0)
#define PG8_MMA8(ai, bj, At, Bt) do { __builtin_amdgcn_s_setprio(1); _Pragma("unroll") for (int m = 0; m < 4; ++m) _Pragma("unroll") for (int n = 0; n < 2; ++n) \
        asm volatile("v_mfma_scale_f32_16x16x128_f8f6f4 %0, %1, %2, %0, %3, %3 op_sel_hi:[0,0,0]" : "+v"(acc[ai][bj][m][n]) : "v"(Bt[n]), "v"(At[m]), "v"(one8)); __builtin_amdgcn_s_setprio(0); } while (0)
#define PG8_MMAI(ai, bj, At, Bt) do { __builtin_amdgcn_s_setprio(1); _Pragma("unroll") for (int m = 0; m < 4; ++m) _Pragma("unroll") for (int n = 0; n < 2; ++n) _Pragma("unroll") for (int k = 0; k < 2; ++k) \
        asm volatile("v_mfma_i32_16x16x64_i8 %0, %1, %2, %0" : "+v"(acc[ai][bj][m][n]) : "v"(Bt[n][k]), "v"(At[m][k])); __builtin_amdgcn_s_setprio(0); } while (0)
#define PG8_WAIT_V(n) asm volatile("s_waitcnt vmcnt(" #n ")" ::: "memory")
#define PG8_WAIT_L(n) asm volatile("s_waitcnt lgkmcnt(" #n ")" ::: "memory")
#define PG8_BAR __builtin_amdgcn_s_barrier()
#define PG8_SCHED __builtin_amdgcn_sched_barrier(0)
    Unit cur, nxt; int ui = 0;
    if (!S.next(0, cur)) return;
    f32x4 acc[2][2][4][2];
#pragma unroll
    for (int a = 0; a < 2; ++a)
#pragma unroll
        for (int b = 0; b < 2; ++b)
#pragma unroll
            for (int m = 0; m < 4; ++m)
#pragma unroll
                for (int n = 0; n < 2; ++n) acc[a][b][m][n] = (f32x4){0.f, 0.f, 0.f, 0.f};
    bf16x8 At[4][2], B0[2][2], B1[2][2];
    bf16x8 At1[4][2];
    int one8 = 0x7F7F7F7F; if constexpr (FP8) asm volatile("" : "+v"(one8));
    i32x8 At8[4], B08[2], B18[2];
    const char* cA = (const char*)g.A + (size_t)cur.pm * tstep; const char* cB = (const char*)g.Bt + (size_t)cur.pn * tstep;
    S.a_ready(cur);
#define PG8_STAGE4(b, pa, pb) do { PG8_STAGE(PG8_SB(b, 0), pb, voffB); PG8_STAGE(PG8_SB(b, 1), (pb) + hstep, voffB); PG8_STAGE(PG8_SA(b, 0), pa, voffA); PG8_STAGE(PG8_SA(b, 1), (pa) + hstep, voffA); } while (0)
#define PG8_MMAX(ai, bj, A_, B_) do { if constexpr (I8) PG8_MMAI(ai, bj, A_, B_); else PG8_MMA(ai, bj, A_, B_); } while (0)
    if constexpr (SP4) {
        PG8_STAGE4(0, cA, cB);
        if (wr == 1) { PG8_STAGE4(1, cA + kstep, cB + kstep); PG8_BAR; PG8_WAIT_V(8); } else { PG8_WAIT_V(0); }
        PG8_BAR; PG8_BAR;
    } else
    if constexpr (SP2) {
        PG8_STAGE(PG8_SB(0, 0), cB, voffB); PG8_STAGE(PG8_SB(0, 1), cB + hstep, voffB); PG8_STAGE(PG8_SA(0, 0), cA, voffA); PG8_STAGE(PG8_SA(0, 1), cA + hstep, voffA);
        if (wr == 1) PG8_BAR;
        PG8_WAIT_V(2); PG8_BAR;
        PG8_STAGE(PG8_SB(1, 0), cB + kstep, voffB); PG8_STAGE(PG8_SA(1, 0), cA + kstep, voffA); PG8_STAGE(PG8_SB(1, 1), cB + hstep + kstep, voffB);
        PG8_WAIT_V(6); PG8_BAR;
    } else {
        PG8_STAGE(PG8_SB(0, 0), cB, voffB); PG8_STAGE(PG8_SA(0, 0), cA, voffA); PG8_STAGE(PG8_SB(0, 1), cB + hstep, voffB); PG8_STAGE(PG8_SA(0, 1), cA + hstep, voffA);
        if (wr == 1) PG8_BAR;
        PG8_WAIT_V(4); PG8_BAR;
        PG8_STAGE(PG8_SB(1, 0), cB + kstep, voffB); PG8_STAGE(PG8_SA(1, 0), cA + kstep, voffA); PG8_STAGE(PG8_SB(1, 1), cB + hstep + kstep, voffB);
        PG8_WAIT_V(6); PG8_BAR;
    }
    for (;;) {
        const bool has_next = S.next(ui + 1, nxt);
        const char* nA = has_next ? (const char*)g.A + (size_t)nxt.pm * tstep : cA; const char* nB = has_next ? (const char*)g.Bt + (size_t)nxt.pn * tstep : cB;
        for (int t = 0; t < nt; t += 2) {
            const bool last = (t == nt - 2);
            const char* a1 = cA + (size_t)(t + 1) * kstep; const char* b1x = cB + (size_t)(t + 1) * kstep;
            const char* a2 = last ? nA : cA + (size_t)(t + 2) * kstep; const char* b2 = last ? nB : cB + (size_t)(t + 2) * kstep;
            const char* a3 = a2 + kstep; const char* b3 = b2 + kstep;
            if (last && has_next) S.a_ready(nxt);
            if constexpr (SP4) {
            PG8_LDB(B0, 0, 0); PG8_LDB(B1, 0, 1); PG8_SCHED; PG8_LDA(At, 0, 0); PG8_LDA(At1, 0, 1);
            if (wr == 0) PG8_STAGE4(1, a1, b1x);
            PG8_WAIT_L(0); if (wr == 1) PG8_WAIT_V(0); PG8_BAR;
            if (wr == 1) PG8_STAGE4(0, a2, b2);
            PG8_MMAX(0, 0, At, B0); PG8_MMAX(0, 1, At, B1); PG8_MMAX(1, 0, At1, B0); PG8_MMAX(1, 1, At1, B1);
            if (wr == 0) PG8_WAIT_V(0); PG8_BAR; PG8_SCHED;
            PG8_LDB(B0, 1, 0); PG8_LDB(B1, 1, 1); PG8_SCHED; PG8_LDA(At, 1, 0); PG8_LDA(At1, 1, 1);
            if (wr == 0) PG8_STAGE4(0, a2, b2);
            PG8_WAIT_L(0); if (wr == 1) PG8_WAIT_V(0); PG8_BAR;
            if (wr == 1) PG8_STAGE4(1, a3, b3);
            PG8_MMAX(0, 0, At, B0); PG8_MMAX(0, 1, At, B1); PG8_MMAX(1, 0, At1, B0); PG8_MMAX(1, 1, At1, B1);
            if (wr == 0) PG8_WAIT_V(0); PG8_BAR; PG8_SCHED;
            } else
            if constexpr (SP2) {
            if constexpr (FP8) {
            PG8_LDB8(B08, 0, 0); PG8_LDB8(B18, 0, 1); PG8_SCHED; PG8_LDA8(At8, 0, 0); PG8_STAGE(PG8_SA(1, 1), a1 + hstep, voffA);
            PG8_WAIT_V(8); PG8_WAIT_L(0); PG8_BAR; PG8_MMA8(0, 0, At8, B08); PG8_MMA8(0, 1, At8, B18); PG8_BAR; PG8_SCHED;
            PG8_LDA8(At8, 0, 1); PG8_STAGE(PG8_SB(0, 0), b2, voffB); PG8_STAGE(PG8_SB(0, 1), b2 + hstep, voffB); PG8_STAGE(PG8_SA(0, 0), a2, voffA);
            PG8_WAIT_V(8); PG8_WAIT_L(0); PG8_BAR; PG8_MMA8(1, 0, At8, B08); PG8_MMA8(1, 1, At8, B18); PG8_BAR; PG8_SCHED;
            PG8_LDB8(B08, 1, 0); PG8_LDB8(B18, 1, 1); PG8_SCHED; PG8_LDA8(At8, 1, 0); PG8_STAGE(PG8_SA(0, 1), a2 + hstep, voffA);
            PG8_WAIT_V(8); PG8_WAIT_L(0); PG8_BAR; PG8_MMA8(0, 0, At8, B08); PG8_MMA8(0, 1, At8, B18); PG8_BAR; PG8_SCHED;
            PG8_LDA8(At8, 1, 1); PG8_STAGE(PG8_SB(1, 0), b3, voffB); PG8_STAGE(PG8_SB(1, 1), b3 + hstep, voffB); PG8_STAGE(PG8_SA(1, 0), a3, voffA);
            PG8_WAIT_V(8); PG8_WAIT_L(0); PG8_BAR; PG8_MMA8(1, 0, At8, B08); PG8_MMA8(1, 1, At8, B18); PG8_BAR; PG8_SCHED;
            } else if constexpr (I8) {
            PG8_LDB(B0, 0, 0); PG8_LDB(B1, 0, 1); PG8_SCHED; PG8_LDA(At, 0, 0); PG8_STAGE(PG8_SA(1, 1), a1 + hstep, voffA);
            PG8_WAIT_V(8); PG8_WAIT_L(0); PG8_BAR; PG8_MMAI(0, 0, At, B0); PG8_MMAI(0, 1, At, B1); PG8_BAR; PG8_SCHED;
            PG8_LDA(At, 0, 1); PG8_STAGE(PG8_SB(0, 0), b2, voffB); PG8_STAGE(PG8_SB(0, 1), b2 + hstep, voffB); PG8_STAGE(PG8_SA(0, 0), a2, voffA);
            PG8_WAIT_V(8); PG8_WAIT_L(0); PG8_BAR; PG8_MMAI(1, 0, At, B0); PG8_MMAI(1, 1, At, B1); PG8_BAR; PG8_SCHED;
            PG8_LDB(B0, 1, 0); PG8_LDB(B1, 1, 1); PG8_SCHED; PG8_LDA(At, 1, 0); PG8_STAGE(PG8_SA(0, 1), a2 + hstep, voffA);
            PG8_WAIT_V(8); PG8_WAIT_L(0); PG8_BAR; PG8_MMAI(0, 0, At, B0); PG8_MMAI(0, 1, At, B1); PG8_BAR; PG8_SCHED;
            PG8_LDA(At, 1, 1); PG8_STAGE(PG8_SB(1, 0), b3, voffB); PG8_STAGE(PG8_SB(1, 1), b3 + hstep, voffB); PG8_STAGE(PG8_SA(1, 0), a3, voffA);
            PG8_WAIT_V(8); PG8_WAIT_L(0); PG8_BAR; PG8_MMAI(1, 0, At, B0); PG8_MMAI(1, 1, At, B1); PG8_BAR; PG8_SCHED;
            } else {
            PG8_LDB(B0, 0, 0); PG8_LDB(B1, 0, 1); PG8_SCHED; PG8_LDA(At, 0, 0); PG8_STAGE(PG8_SA(1, 1), a1 + hstep, voffA);
            PG8_WAIT_V(8); PG8_WAIT_L(0); PG8_BAR; PG8_MMA(0, 0, At, B0); PG8_MMA(0, 1, At, B1); PG8_BAR; PG8_SCHED;
            PG8_LDA(At, 0, 1); PG8_STAGE(PG8_SB(0, 0), b2, voffB); PG8_STAGE(PG8_SB(0, 1), b2 + hstep, voffB); PG8_STAGE(PG8_SA(0, 0), a2, voffA);
            PG8_WAIT_V(8); PG8_WAIT_L(0); PG8_BAR; PG8_MMA(1, 0, At, B0); PG8_MMA(1, 1, At, B1); PG8_BAR; PG8_SCHED;
            PG8_LDB(B0, 1, 0); PG8_LDB(B1, 1, 1); PG8_SCHED; PG8_LDA(At, 1, 0); PG8_STAGE(PG8_SA(0, 1), a2 + hstep, voffA);
            PG8_WAIT_V(8); PG8_WAIT_L(0); PG8_BAR; PG8_MMA(0, 0, At, B0); PG8_MMA(0, 1, At, B1); PG8_BAR; PG8_SCHED;
            PG8_LDA(At, 1, 1); PG8_STAGE(PG8_SB(1, 0), b3, voffB); PG8_STAGE(PG8_SB(1, 1), b3 + hstep, voffB); PG8_STAGE(PG8_SA(1, 0), a3, voffA);
            PG8_WAIT_V(8); PG8_WAIT_L(0); PG8_BAR; PG8_MMA(1, 0, At, B0); PG8_MMA(1, 1, At, B1); PG8_BAR; PG8_SCHED;
            }
            } else {
            PG8_LDB(B0, 0, 0); PG8_SCHED; PG8_LDA(At, 0, 0); PG8_STAGE(PG8_SA(1, 1), a1 + hstep, voffA);
            PG8_WAIT_L(8); PG8_BAR; PG8_WAIT_L(0); PG8_MMA(0, 0, At, B0); PG8_BAR; PG8_SCHED;
            PG8_LDB(B1, 0, 1); PG8_STAGE(PG8_SB(0, 0), b2, voffB);
            PG8_BAR; PG8_WAIT_L(0); PG8_MMA(0, 1, At, B1); PG8_BAR;
            PG8_LDA(At, 0, 1); PG8_STAGE(PG8_SA(0, 0), a2, voffA);
            PG8_BAR; PG8_WAIT_L(0); PG8_MMA(1, 0, At, B0); PG8_BAR; PG8_SCHED;
            PG8_STAGE(PG8_SB(0, 1), b2 + hstep, voffB);
            PG8_WAIT_V(6); PG8_BAR; PG8_MMA(1, 1, At, B1); PG8_BAR;
            PG8_LDB(B0, 1, 0); PG8_SCHED; PG8_LDA(At, 1, 0); PG8_STAGE(PG8_SA(0, 1), a2 + hstep, voffA);
            PG8_WAIT_L(8); PG8_BAR; PG8_WAIT_L(0); PG8_MMA(0, 0, At, B0); PG8_BAR; PG8_SCHED;
            PG8_LDB(B1, 1, 1); PG8_STAGE(PG8_SB(1, 0), b3, voffB);
            PG8_BAR; PG8_WAIT_L(0); PG8_MMA(0, 1, At, B1); PG8_BAR;
            PG8_LDA(At, 1, 1); PG8_STAGE(PG8_SA(1, 0), a3, voffA);
            PG8_BAR; PG8_WAIT_L(0); PG8_MMA(1, 0, At, B0); PG8_BAR; PG8_SCHED;
            PG8_STAGE(PG8_SB(1, 1), b3 + hstep, voffB);
            PG8_WAIT_V(6); PG8_BAR; PG8_MMA(1, 1, At, B1); PG8_BAR;
            }
        }
        if constexpr (ALIGN_EPI) { if (wr == 0) PG8_BAR; }
        if constexpr (!Epi::AFTER_DRAIN) { int l2_ = (int)__builtin_amdgcn_mbcnt_hi(~0u, __builtin_amdgcn_mbcnt_lo(~0u, 0u)); asm volatile("" : "+v"(l2_));
            E(acc, cur, wr, wc, l2_ & 15, l2_ >> 4); S.done(cur); }
        if (!has_next) break;
#pragma unroll
        for (int a = 0; a < 2; ++a)
#pragma unroll
            for (int b = 0; b < 2; ++b)
#pragma unroll
                for (int m = 0; m < 4; ++m)
#pragma unroll
                    for (int n = 0; n < 2; ++n) acc[a][b][m][n] = (f32x4){0.f, 0.f, 0.f, 0.f};
        cur = nxt; cA = nA; cB = nB; ++ui;
        if constexpr (ALIGN_EPI) { if (wr == 1) PG8_BAR; }
    }
    PG8_WAIT_V(0);
    if constexpr (!ALIGN_EPI) { if (wr == 0) PG8_BAR; }
    PG8_BAR;
    if constexpr (Epi::AFTER_DRAIN) { E.fused(acc, cur, wr, wc, fr, fq, lds, wid, lane); S.done(cur); }
#undef PG8_SA
#undef PG8_SB
#undef PG8_STAGE
#undef PG8_DMA
#undef PG8_LDA
#undef PG8_LDB
#undef PG8_MMA
#undef PG8_LDA8
#undef PG8_LDB8
#undef PG8_MMA8
#undef PG8_MMAI
#undef PG8_STAGE4
#undef PG8_MMAX
#undef PG8_WAIT_V
#undef PG8_WAIT_L
#undef PG8_BAR
#undef PG8_SCHED
}
}

constexpr int SEQ = 8192, DM = 4096, NQH = 32, NKVH = 8, HD = 128, INW = 16384, DFF = 16384, SSMW = 2048, NGRP = 128, NST = 64, NMOD = 6 * DM;
constexpr float EPS = 1e-6f, LOG2E = 1.4426950408889634f;
constexpr int NWAVES = 8, NTHR = 512;

constexpr size_t MiB = 1u << 20;
constexpr size_t WS_CTL = 0, CTL_ZERO_BYTES = MiB / 4;
constexpr size_t WS_MODP = 1 * MiB;
constexpr size_t WS_MOD = 2 * MiB;
constexpr size_t WS_ROPE = 3 * MiB;
constexpr size_t WS_F = 4 * MiB;
constexpr size_t WS_WIN = 16 * MiB, WS_WGLU = 144 * MiB, WS_WOUT = 176 * MiB, WS_WFF1 = 208 * MiB, WS_WFF2 = 336 * MiB;
constexpr size_t WS_H = 464 * MiB;
constexpr size_t WS_Q = 528 * MiB, WS_K = 592 * MiB, WS_V = 608 * MiB;
constexpr size_t WS_U = 624 * MiB;
constexpr size_t WS_GA = 688 * MiB, WS_GS = 752 * MiB;
constexpr size_t WS_ATT = 816 * MiB;
constexpr size_t WS_YG = 880 * MiB;
constexpr size_t WS_MRG = 912 * MiB;
constexpr size_t WS_FFH = 976 * MiB;
constexpr size_t WS_H8 = 1232 * MiB;
constexpr size_t WS_WG8 = WS_WIN;
constexpr size_t WS_WINU = WS_WIN + 64 * MiB;
constexpr size_t WS_HI8 = 1264 * MiB;
constexpr size_t WS_MRGI8 = 1296 * MiB;
constexpr size_t WS_MMAX = 1328 * MiB;
constexpr size_t WS_SAH = 1332 * MiB, WS_SAM = WS_SAH + 65536;
constexpr size_t WS_END = 1333 * MiB;
constexpr size_t WS_WMAXU = WS_CTL + 196608, WS_WMAXO = WS_CTL + 204800;
constexpr size_t WS_BIAS2 = WS_CTL + 65536;
constexpr size_t WS_SSQ = 12 * MiB;
constexpr int CW_BAR = 4096;

constexpr int RING_BYTES = 131072;
constexpr int XCH_OFF = RING_BYTES, XCH_BYTES = 8192;
constexpr int MISC_OFF = 147456;
constexpr int LDS_BYTES = MISC_OFF + 256;

#define GAS __attribute__((address_space(1)))
#define LAS __attribute__((address_space(3)))
typedef unsigned short bf16;
typedef unsigned u32x4 __attribute__((ext_vector_type(4)));
typedef unsigned u32x2 __attribute__((ext_vector_type(2)));
typedef float f32x4 __attribute__((ext_vector_type(4)));
typedef float f32x16 __attribute__((ext_vector_type(16)));
typedef short bf16x8 __attribute__((ext_vector_type(8)));
typedef short s16x4 __attribute__((ext_vector_type(4)));
typedef GAS unsigned gu32;
#define RLX_AGENT __ATOMIC_RELAXED, __HIP_MEMORY_SCOPE_AGENT
#define LDS_WAIT() asm volatile("s_waitcnt lgkmcnt(0)" ::: "memory")
#define VM_WAIT() asm volatile("s_waitcnt vmcnt(0)" ::: "memory")
using pg8::cvt_pk_bf16;
typedef float f32x2 __attribute__((ext_vector_type(2)));
#define XB_TMO      128
#define XB_XCNT(j)  (256  + 64 * (j))
#define XB_XSUB(j)  (1280 + 64 * (j))
#define XB_XGEN(j)  (2304 + 64 * (j))
#define XB_TOP      3328
#define XB_TOPGEN   3392
#define XCD_BAR_WORDS 3456
#define XB_SPIN_CAP (1u << 18)

__device__ __forceinline__ unsigned xb_ld(unsigned* p)              { return __hip_atomic_load(p, __ATOMIC_RELAXED, __HIP_MEMORY_SCOPE_AGENT); }
__device__ __forceinline__ unsigned xb_add(unsigned* p, unsigned v) { return __hip_atomic_fetch_add(p, v, __ATOMIC_RELAXED, __HIP_MEMORY_SCOPE_AGENT); }
__device__ __forceinline__ unsigned xb_xcc_id() { return (unsigned)__builtin_amdgcn_s_getreg((3 << 11) | 20) & 0xFu; }
#define XB_SPIN(cond, bar) do { unsigned _sp = 0; while (cond) { __builtin_amdgcn_s_sleep(1); \
    if ((++_sp & 255u) == 0u) { if (xb_ld(&(bar)[XB_TMO])) break; if (_sp > XB_SPIN_CAP) { atomicAdd(&(bar)[XB_TMO], 1u); break; } } } } while (0)

struct XcdBarrier {
    unsigned* bar; unsigned x; int wave;
    volatile LAS unsigned* st;
};

__device__ __forceinline__ int xb_lane_id() { return (int)__builtin_amdgcn_mbcnt_hi(~0u, __builtin_amdgcn_mbcnt_lo(~0u, 0u)); }
__device__ __forceinline__ XcdBarrier xcd_barrier_post(unsigned* bar, volatile LAS unsigned* st) {
    XcdBarrier b; b.bar = bar; b.x = xb_xcc_id(); b.st = st; b.wave = __builtin_amdgcn_readfirstlane((int)(threadIdx.x >> 6));
    if (threadIdx.x == 0) (void)xb_add(&bar[XB_XCNT(b.x)], 1u);
    return b;
}
__device__ __forceinline__ void xcd_barrier_complete(unsigned* bar, unsigned x, unsigned& nloc, unsigned& nx) {
    const unsigned G = gridDim.x * gridDim.y * gridDim.z;
    unsigned sum, cnt, mine, sp = 0u;
    for (;;) {
        sum = 0u; cnt = 0u; mine = 0u;
#pragma unroll
        for (unsigned j = 0; j < 16; ++j) { const unsigned c = xb_ld(&bar[XB_XCNT(j)]); sum += c; cnt += (c > 0u) ? 1u : 0u; mine = (j == x) ? c : mine; }
        if (sum == G) break;
        __builtin_amdgcn_s_sleep(1);
        if ((++sp & 255u) == 0u) { if (xb_ld(&bar[XB_TMO])) break; if (sp > XB_SPIN_CAP) { atomicAdd(&bar[XB_TMO], 1u); break; } }
    }
    nloc = mine > 0u ? mine : 1u; nx = cnt > 0u ? cnt : 1u;
}

__device__ __forceinline__ void xcd_barrier(const XcdBarrier& b) {
    asm volatile("s_waitcnt vmcnt(0)" ::: "memory");
    __syncthreads();
    if (b.wave == 0 && xb_lane_id() == 0) {
        unsigned* bar = b.bar;
        __builtin_amdgcn_s_waitcnt(0);
        unsigned nloc = b.st[0], nx = b.st[1];
        if (nloc == 0u) { xcd_barrier_complete(bar, b.x, nloc, nx); b.st[0] = nloc; b.st[1] = nx; }
        const unsigned old = xb_add(&bar[XB_XSUB(b.x)], 1u);
        const unsigned gen = old / nloc;
        if (old + 1u == (gen + 1u) * nloc) {
            __builtin_amdgcn_fence(__ATOMIC_RELEASE, "agent");
            asm volatile("s_waitcnt vmcnt(0)" ::: "memory");
            const unsigned og = xb_add(&bar[XB_TOP], 1u);
            const unsigned tg = og / nx;
            if (og + 1u == (tg + 1u) * nx) xb_add(&bar[XB_TOPGEN], 1u);
            else XB_SPIN(xb_ld(&bar[XB_TOPGEN]) == tg, bar);
            __builtin_amdgcn_fence(__ATOMIC_ACQUIRE, "agent");
            xb_add(&bar[XB_XGEN(b.x)], 1u);
            asm volatile("s_waitcnt vmcnt(0)" ::: "memory");
        } else {
            XB_SPIN(xb_ld(&bar[XB_XGEN(b.x)]) == gen, bar);
            __builtin_amdgcn_fence(__ATOMIC_ACQUIRE, "agent");
            asm volatile("s_waitcnt vmcnt(0)" ::: "memory");
        }
    }
    __syncthreads();
}

__device__ __forceinline__ float wave_sum(float v) {
#pragma unroll
    for (int o = 1; o < 64; o <<= 1) v += __shfl_xor(v, o);
    return v;
}
__device__ __forceinline__ int inv_perm32(int l) { return 16 * ((l >> 2) & 1) + 4 * (l >> 3) + (l & 3); }
template <int MODE> __device__ __forceinline__ int phys_row(int n) {
    if (MODE == 1 && n < 5120) return n;
    if (MODE == 2) { const int bj = n >> 12, ch = n & 4095; return 256 * (ch >> 7) + 128 * bj + (ch & 96) + inv_perm32(ch & 31); }
    return (n & ~31) + inv_perm32(n & 31);
}
using pg8::pk4_i8;
__device__ __forceinline__ float i8f(unsigned w, int i) { return (float)((int)(w << (24 - 8 * i)) >> 24); }
struct TrItem { const float* W; bf16* WT; int K, N, mode, k0, n0, fp8, i8; const unsigned* wmax; const float* addv; float* bias; const float* rowscale; };
__device__ __forceinline__ int phys_row_rt(int mode, int n) {
    if (mode == 1 && n < 5120) return n;
    if (mode == 2) { const int bj = n >> 12, ch = n & 4095; return 256 * (ch >> 7) + 128 * bj + (ch & 96) + inv_perm32(ch & 31); }
    return (n & ~31) + inv_perm32(n & 31);
}
__device__ __forceinline__ void tr_load(const TrItem& d, float (&v)[64], int lane) {
    const float* src = d.W + (size_t)d.k0 * d.N + d.n0 + lane;
#pragma unroll
    for (int i = 0; i < 64; ++i) v[i] = __builtin_nontemporal_load(src + (size_t)i * d.N);
}
__device__ __forceinline__ void tr_finish(const TrItem& d, const float (&v)[64], LAS float* scr, int lane) {
    if (d.bias) { float s = 0.f;
#pragma unroll
        for (int i = 0; i < 64; ++i) s += d.addv[d.k0 + i] * v[i];
        atomicAdd(d.bias + d.n0 + lane, s); }
    if (d.i8) {
        const float cm = __uint_as_float(d.wmax[(d.mode == 5 ? d.n0 - 6144 : d.n0) + lane]), inv = cm > 0.f ? 127.0f / cm : 0.f;
#pragma unroll
        for (int i = 0; i < 64; ++i) scr[i * 65 + lane] = v[i] * inv;
        LDS_WAIT();
        const int c8 = lane & 7;
#pragma unroll
        for (int j = 0; j < 8; ++j) { const int n = (lane >> 3) + 8 * j; const LAS float* s = scr + (8 * c8) * 65 + n;
            u32x2 o; o.x = pk4_i8(s[0 * 65], s[1 * 65], s[2 * 65], s[3 * 65]); o.y = pk4_i8(s[4 * 65], s[5 * 65], s[6 * 65], s[7 * 65]);
            const int row = d.mode == 5 ? phys_row_rt(0, d.n0 - 6144 + n) : phys_row_rt(d.mode, d.n0 + n);
            *(u32x2*)((unsigned char*)d.WT + (size_t)row * d.K + d.k0 + 8 * c8) = o; }
        LDS_WAIT(); return;
    }
    if (d.rowscale) {
#pragma unroll
        for (int i = 0; i < 64; ++i) scr[i * 65 + lane] = v[i] * d.rowscale[d.k0 + i];
    } else {
#pragma unroll
        for (int i = 0; i < 64; ++i) scr[i * 65 + lane] = v[i];
    }
    LDS_WAIT();
    const int c = lane & 7;
    if (d.fp8) {
#pragma unroll
        for (int j = 0; j < 8; ++j) { const int n = (lane >> 3) + 8 * j; const LAS float* s = scr + (8 * c) * 65 + n;
            u32x2 o; o.x = pg8::pk4_fp8(s[0 * 65] * pg8::W8_SCALE, s[1 * 65] * pg8::W8_SCALE, s[2 * 65] * pg8::W8_SCALE, s[3 * 65] * pg8::W8_SCALE);
            o.y = pg8::pk4_fp8(s[4 * 65] * pg8::W8_SCALE, s[5 * 65] * pg8::W8_SCALE, s[6 * 65] * pg8::W8_SCALE, s[7 * 65] * pg8::W8_SCALE);
            const int nn = d.n0 + n, row = d.mode != 3 ? phys_row_rt(d.mode, nn) : (nn < 6144 ? phys_row_rt(1, nn) : 6144 + phys_row_rt(0, nn - 8192));
            *(u32x2*)((unsigned char*)d.WT + (size_t)row * d.K + d.k0 + 8 * c) = o; }
        LDS_WAIT(); return;
    }
#pragma unroll
    for (int j = 0; j < 8; ++j) { const int n = (lane >> 3) + 8 * j; const LAS float* s = scr + (8 * c) * 65 + n;
        u32x4 o; o.x = cvt_pk_bf16(s[0 * 65], s[1 * 65]); o.y = cvt_pk_bf16(s[2 * 65], s[3 * 65]); o.z = cvt_pk_bf16(s[4 * 65], s[5 * 65]); o.w = cvt_pk_bf16(s[6 * 65], s[7 * 65]);
        const int row = d.mode == 5 ? phys_row_rt(0, d.n0 - 6144 + n) : phys_row_rt(d.mode, d.n0 + n);
        *(u32x4*)(d.WT + (size_t)row * d.K + d.k0 + 8 * c) = o; }
    LDS_WAIT();
}

struct Ptrs {
    const float *x, *c, *w_ada, *b_ada, *n1g, *n2g, *w_in, *qng, *kng, *sinks, *lam_re, *lam_im, *log_dt, *b_re, *b_im, *c_re, *c_im, *dsk, *w_glu, *w_out, *w_ff1, *w_ff2;
    const int* pos; float* out;
    float *MODP, *MOD, *ROPE, *F, *BIAS2, *SSQ;
    unsigned char *H8, *WG8, *HI8, *MRGI8; bf16* WINU; float *MMAX, *SAH, *SAM; unsigned *WMAXU, *WMAXO;
    bf16 *WIN, *WGLU, *WOUT, *WFF1, *WFF2, *H, *Q, *K, *V, *ATT, *YG, *FFH, *U; unsigned char *GA, *GS, *MRG;
};

constexpr int TI_IN = (DM / 64) * 224;
constexpr int TI_U = (DM / 64) * 32;
constexpr int TI_CM = TI_U + (DM / 64) * (DM / 64);
constexpr int TI_GLU = (SSMW / 64) * (2 * DM / 64), TI_OUT = (DM / 64) * (DM / 64), TI_FF1 = (DM / 64) * (DFF / 64), TI_FF2 = (DFF / 64) * (DM / 64), TI_ALL = TI_GLU + TI_OUT + TI_FF1 + TI_FF2;
template <int LIST> __device__ __forceinline__ TrItem tr_decode(const Ptrs& P, int r) {
    TrItem d; d.addv = nullptr; d.bias = nullptr; d.fp8 = 0; d.rowscale = nullptr; d.i8 = 0; d.wmax = nullptr;
    if (LIST == 0 || LIST == 2) { d.W = P.w_in; d.WT = P.WIN; d.K = DM; d.N = INW; d.mode = 1; }
    else if (r < TI_GLU) { d.W = P.w_glu; d.WT = P.WGLU; d.K = SSMW; d.N = 2 * DM; d.mode = 2; d.fp8 = 1; }
    else if (r < TI_GLU + TI_OUT) { r -= TI_GLU; d.W = P.w_out; d.WT = P.WOUT; d.K = DM; d.N = DM; d.mode = 0; d.i8 = 1; d.wmax = P.WMAXO; }
    else if (r < TI_GLU + TI_OUT + TI_FF1) { r -= TI_GLU + TI_OUT; d.W = P.w_ff1; d.WT = P.WFF1; d.K = DM; d.N = DFF; d.mode = 0; d.addv = P.MOD + 3 * DM; d.bias = P.BIAS2; d.rowscale = P.MOD + 6 * DM; }
    else { r -= TI_GLU + TI_OUT + TI_FF1; d.W = P.w_ff2; d.WT = P.WFF2; d.K = DFF; d.N = DM; d.mode = 0; }
    if (LIST == 0) { const int nb = r % 224; d.k0 = 64 * (r / 224); d.n0 = 64 * (nb < 96 ? nb : nb + 32); d.mode = 3; d.fp8 = 1; d.WT = (bf16*)P.WG8; }
    else if (LIST == 2) { d.k0 = 64 * (r / 32); d.n0 = 6144 + 64 * (r % 32); d.mode = 5; d.i8 = 1; d.wmax = P.WMAXU; d.WT = P.WINU; }
    else { const int nblk = d.N / 64; d.k0 = 64 * (r / nblk); d.n0 = 64 * (r % nblk); }
    return d;
}
__device__ __forceinline__ int pool_grab(LAS unsigned* ctr, int lo, int lane) {
    unsigned k = 0u; if (lane == 0) k = __hip_atomic_fetch_add(ctr, 1u, __ATOMIC_RELAXED, __HIP_MEMORY_SCOPE_WORKGROUP);
    return lo + (int)__builtin_amdgcn_readfirstlane(k);
}
template <int LIST> __device__ __forceinline__ void transpose_pool(const Ptrs& P, int lo, int hi, LAS unsigned* ctr, LAS float* scr, int lane) {
    float va[64], vb[64];
    int r0 = pool_grab(ctr, lo, lane); if (r0 >= hi) return;
    TrItem d0 = tr_decode<LIST>(P, r0), d1 = d0; tr_load(d0, va, lane);
    for (;;) {
        const int r1 = pool_grab(ctr, lo, lane);
        if (r1 < hi) { d1 = tr_decode<LIST>(P, r1); tr_load(d1, vb, lane); }
        tr_finish(d0, va, scr, lane);
        if (r1 >= hi) break;
        r0 = pool_grab(ctr, lo, lane);
        if (r0 < hi) { d0 = tr_decode<LIST>(P, r0); tr_load(d0, va, lane); }
        tr_finish(d1, vb, scr, lane);
        if (r0 >= hi) break;
    }
}

__device__ __forceinline__ void phase0(const Ptrs& P, LAS unsigned char* lds, int bx, int G, int tid, int wave, int lane) {
    LAS float* red = (LAS float*)lds;
    for (int j = bx; j < 96 * 8; j += G) {
        const int chunk = j % 96, kg = j / 96, k0 = kg * 512 + wave * 64;
        float cv = P.c[k0 + lane]; cv = cv / (1.0f + expf(-cv));
        f32x4 acc = {0.f, 0.f, 0.f, 0.f};
        const float* wp = P.w_ada + (size_t)k0 * NMOD + chunk * 256 + lane * 4;
#pragma unroll 16
        for (int kk = 0; kk < 64; ++kk) { const f32x4 w = __builtin_nontemporal_load((const f32x4*)(wp + (size_t)kk * NMOD)); const float a = __int_as_float(__builtin_amdgcn_readlane(__float_as_int(cv), kk)); acc += w * a; }
        *(LAS f32x4*)(red + wave * 256 + lane * 4) = acc;
        __syncthreads();
        if (tid < 256) { float s = 0.f;
#pragma unroll
            for (int w = 0; w < 8; ++w) s += red[w * 256 + tid];
            P.MODP[(size_t)kg * NMOD + chunk * 256 + tid] = s; }
        __syncthreads();
    }
    { const int gwc = bx * NWAVES + wave, NGWC = G * NWAVES;
      for (int it = gwc; it < TI_CM; it += NGWC) {
          const bool isu = it < TI_U; const int r = isu ? it : it - TI_U, nblk = isu ? 32 : DM / 64, N = isu ? INW : DM;
          const int k0 = 64 * (r / nblk), nb = r % nblk, n0 = isu ? 6144 + 64 * nb : 64 * nb;
          const float* src = (isu ? P.w_in : P.w_out) + (size_t)k0 * N + n0 + lane;
          float m0 = 0.f, m1 = 0.f;
#pragma unroll 16
          for (int i = 0; i < 64; i += 2) { m0 = fmaxf(m0, fabsf(__builtin_nontemporal_load(src + (size_t)i * N))); m1 = fmaxf(m1, fabsf(__builtin_nontemporal_load(src + (size_t)(i + 1) * N))); }
          atomicMax((isu ? P.WMAXU : P.WMAXO) + 64 * nb + lane, __float_as_uint(fmaxf(m0, m1)));
      } }
    { const int per = (TI_IN + G - 1) / G, lo = bx * per, hi = (lo + per < TI_IN) ? lo + per : TI_IN;
      transpose_pool<0>(P, lo, hi, (LAS unsigned*)(lds + MISC_OFF) + 18, (LAS float*)(lds + wave * 16640), lane); }
}

__device__ __forceinline__ void norm_row(const float* xrow, unsigned char* orow8, unsigned char* orowi, float* sa, const LAS float* mult, const LAS float* add, int lane) {
    const f32x4* xr = (const f32x4*)xrow + lane;
    f32x4 v[16]; float ss = 0.f;
#pragma unroll
    for (int j = 0; j < 16; ++j) { v[j] = xr[64 * j]; ss += (v[j][0] * v[j][0] + v[j][1] * v[j][1]) + (v[j][2] * v[j][2] + v[j][3] * v[j][3]); }
    const float rstd = 1.0f / sqrtf(wave_sum(ss) * (1.0f / DM) + EPS);
    float am = 0.f;
#pragma unroll
    for (int j = 0; j < 16; ++j) { const f32x4 m = *(const LAS f32x4*)(mult + 4 * lane + 256 * j), a = *(const LAS f32x4*)(add + 4 * lane + 256 * j);
        v[j] = v[j] * rstd * m + a; am = fmaxf(fmaxf(am, fmaxf(fabsf(v[j][0]), fabsf(v[j][1]))), fmaxf(fabsf(v[j][2]), fabsf(v[j][3])));
        if ((j & 3) == 3) asm volatile("" ::: "memory"); }
#pragma unroll
    for (int o = 1; o < 64; o <<= 1) am = fmaxf(am, __shfl_xor(am, o));
    const float inv = am > 0.f ? 127.0f / am : 0.f;
    if (lane == 0) *sa = am * (1.0f / 127.0f);
    unsigned* o4 = (unsigned*)orow8 + lane; unsigned* oi = (unsigned*)orowi + lane;
#pragma unroll
    for (int j = 0; j < 16; ++j) { const f32x4 y = v[j]; o4[64 * j] = pg8::pk4_fp8(y[0], y[1], y[2], y[3]); oi[64 * j] = pk4_i8(y[0] * inv, y[1] * inv, y[2] * inv, y[3] * inv); }
}
__device__ __forceinline__ void quant_row(const unsigned char* mrow, const float* pmax, unsigned char* orowi, float* sa, int lane) {
    float am = fmaxf(pmax[lane], pmax[64 + lane]);
#pragma unroll
    for (int o = 1; o < 64; o <<= 1) am = fmaxf(am, __shfl_xor(am, o));
    const float inv = am > 0.f ? 1.0f / am : 0.f;
    if (lane == 0) *sa = am * (1.0f / 127.0f);
    const u32x4* mr = (const u32x4*)mrow + lane; u32x4* oi = (u32x4*)orowi + lane;
    u32x4 w[4]; float f[4];
#pragma unroll
    for (int j = 0; j < 4; ++j) { w[j] = mr[64 * j]; f[j] = pmax[(lane >> 1) + 32 * j] * inv; }
#pragma unroll
    for (int j = 0; j < 4; ++j) { u32x4 o;
#pragma unroll
        for (int c = 0; c < 4; ++c) { const unsigned x = w[j][c]; o[c] = pk4_i8(i8f(x, 0) * f[j], i8f(x, 1) * f[j], i8f(x, 2) * f[j], i8f(x, 3) * f[j]); }
        oi[64 * j] = o; }
}

__device__ __forceinline__ void phase1(const Ptrs& P, LAS unsigned char* lds, int bx, int G, int tid, int wave, int lane) {
    LAS float* mult = (LAS float*)lds; LAS float* add = mult + DM;
    for (int c = tid; c < DM; c += NTHR) {
        float sh = P.b_ada[c], sc = P.b_ada[DM + c];
#pragma unroll
        for (int p = 0; p < 8; ++p) { sh += P.MODP[(size_t)p * NMOD + c]; sc += P.MODP[(size_t)p * NMOD + DM + c]; }
        mult[c] = P.n1g[c] * (1.0f + sc); add[c] = sh;
    }
    for (int col = bx * NTHR + tid; col < NMOD; col += G * NTHR) {
        float s = P.b_ada[col];
#pragma unroll
        for (int p = 0; p < 8; ++p) s += P.MODP[(size_t)p * NMOD + col];
        P.MOD[col] = s;
        if (col >= 4 * DM && col < 5 * DM) P.MOD[6 * DM + (col - 4 * DM)] = P.n2g[col - 4 * DM] * (1.0f + s);
    }
    const int gw = bx * NWAVES + wave, NGW = G * NWAVES;
    for (int r4 = gw; r4 < SEQ / 4; r4 += NGW) {
        const int row = r4 * 4 + (lane >> 4), i = lane & 15;
        const float inv_freq = powf(500000.0f, -2.0f * (float)i / 32.0f);
        const float ang = (float)P.pos[row] * inv_freq;
        P.ROPE[(size_t)row * 32 + i] = cosf(ang); P.ROPE[(size_t)row * 32 + 16 + i] = sinf(ang);
    }
    __syncthreads();
    for (int row = gw; row < SEQ; row += NGW) norm_row(P.x + (size_t)row * DM, P.H8 + (size_t)row * DM, P.HI8 + (size_t)row * DM, P.SAH + row, mult, add, lane);
    { const int per = (TI_U + G - 1) / G, lo = bx * per, hi = (lo + per < TI_U) ? lo + per : TI_U;
      __syncthreads();
      transpose_pool<2>(P, lo, hi, (LAS unsigned*)(lds + MISC_OFF) + 19, (LAS float*)(lds + wave * 16640), lane); }
}
__device__ __forceinline__ int crow(int r, int h) { return (r & 3) + 8 * (r >> 2) + 4 * h; }
#define MFMA32(a, b, c) __builtin_amdgcn_mfma_f32_32x32x16_bf16((a), (b), (c), 0, 0, 0)
#define MFMA16(a, b, c) __builtin_amdgcn_mfma_f32_16x16x32_bf16((a), (b), (c), 0, 0, 0)
constexpr int ATT_KP = 272, ATT_VP = 520, ATT_VOFF = 256 * ATT_KP;
static_assert(ATT_VOFF + 128 * ATT_VP <= MISC_OFF, "attention LDS");
__device__ __forceinline__ void attn_unit(const Ptrs& P, int qb, int kh, LAS unsigned char* lds, int tid, int wave, int lane) {
    const bool hasprev = qb > 0;
#pragma unroll
    for (int i = 0; i < 8; ++i) {
        const int c = tid + NTHR * i, key = c >> 4, part = c & 15; u32x4 v = {0u, 0u, 0u, 0u};
        if (hasprev || key >= 128) v = *(const u32x4*)(P.K + (size_t)(128 * (qb - 1) + key) * 1024 + kh * 128 + part * 8);
        *(LAS u32x4*)(lds + key * ATT_KP + part * 16) = v;
    }
#pragma unroll
    for (int i = 0; i < 8; ++i) {
        const int c = tid + NTHR * i, key = c & 255, part = c >> 8; u32x4 v = {0u, 0u, 0u, 0u};
        if (hasprev || key >= 128) v = *(const u32x4*)(P.V + (size_t)(128 * (qb - 1) + key) * 1024 + kh * 128 + part * 8);
#pragma unroll
        for (int e = 0; e < 8; ++e) *(LAS unsigned short*)(lds + ATT_VOFF + (part * 8 + e) * ATT_VP + key * 2) = (unsigned short)((v[e >> 1] >> (16 * (e & 1))) & 0xffffu);
    }
    __syncthreads();
    const int hq = 4 * kh + (wave >> 1), qh = wave & 1, r = lane & 31, h = lane >> 5;
    const float sink2 = P.sinks[hq] * LOG2E;
    const float NEG = -__builtin_inff();
#pragma unroll 1
    for (int qq = 0; qq < 2; ++qq) {
        const int i0 = 64 * qh + 32 * qq;
        const size_t qrow = (size_t)(128 * qb + i0 + r);
        bf16x8 qf[8];
#pragma unroll
        for (int ks = 0; ks < 8; ++ks) qf[ks] = *(const bf16x8*)(P.Q + qrow * 4096 + hq * 128 + 16 * ks + 8 * h);
        f32x16 st[5];
#pragma unroll
        for (int t = 0; t < 5; ++t) {
#pragma unroll
            for (int e = 0; e < 16; ++e) st[t][e] = 0.f;
#pragma unroll
            for (int ks = 0; ks < 8; ++ks) { const bf16x8 kf = *(const LAS bf16x8*)(lds + (i0 + 32 * t + r) * ATT_KP + (16 * ks + 8 * h) * 2); st[t] = MFMA32(kf, qf[ks], st[t]); }
        }
#pragma unroll
        for (int e = 0; e < 16; ++e) { const int cr = crow(e, h); if (cr <= r) st[0][e] = NEG; if (cr > r) st[4][e] = NEG; }
        if (!hasprev) {
#pragma unroll
            for (int t = 0; t < 5; ++t) if (i0 + 32 * t < 128) {
#pragma unroll
                for (int e = 0; e < 16; ++e) st[t][e] = NEG; }
        }
        float m = sink2;
#pragma unroll
        for (int t = 0; t < 5; ++t)
#pragma unroll
            for (int e = 0; e < 16; ++e) m = fmaxf(m, st[t][e]);
        m = fmaxf(m, __shfl_xor(m, 32));
        float l = 0.f;
#pragma unroll
        for (int t = 0; t < 5; ++t)
#pragma unroll
            for (int e = 0; e < 16; ++e) { const float p = __builtin_amdgcn_exp2f(st[t][e] - m); st[t][e] = p; l += p; }
        l += __shfl_xor(l, 32);
        l += __builtin_amdgcn_exp2f(sink2 - m);
        bf16x8 pf[5][2];
#pragma unroll
        for (int t = 0; t < 5; ++t)
#pragma unroll
            for (int s = 0; s < 2; ++s) { u32x4 w; w.x = cvt_pk_bf16(st[t][8 * s + 0], st[t][8 * s + 1]); w.y = cvt_pk_bf16(st[t][8 * s + 2], st[t][8 * s + 3]); w.z = cvt_pk_bf16(st[t][8 * s + 4], st[t][8 * s + 5]); w.w = cvt_pk_bf16(st[t][8 * s + 6], st[t][8 * s + 7]);
                pf[t][s] = __builtin_bit_cast(bf16x8, w); }
        const float inv = (1.0f / 255.0f) / l;
#pragma unroll
        for (int db = 0; db < 4; ++db) {
            f32x16 o;
#pragma unroll
            for (int e = 0; e < 16; ++e) o[e] = 0.f;
#pragma unroll
            for (int t = 0; t < 5; ++t)
#pragma unroll
                for (int s = 0; s < 2; ++s) {
                    const LAS unsigned char* vp = lds + ATT_VOFF + (32 * db + r) * ATT_VP + (i0 + 32 * t + 16 * s + 4 * h) * 2;
                    const s16x4 lo = *(const LAS s16x4*)vp, hi = *(const LAS s16x4*)(vp + 16);
                    const bf16x8 vf = __builtin_shufflevector(lo, hi, 0, 1, 2, 3, 4, 5, 6, 7);
                    o = MFMA32(vf, pf[t][s], o);
                }
            unsigned gav[4];
#pragma unroll
            for (int g4 = 0; g4 < 4; ++g4) gav[g4] = *(const unsigned*)(P.GA + qrow * 4096 + hq * 128 + 32 * db + 8 * g4 + 4 * h);
#pragma unroll
            for (int g4 = 0; g4 < 4; ++g4) { u32x2 w;
                w.x = cvt_pk_bf16(o[4 * g4 + 0] * inv * pg8::u8f(gav[g4], 0), o[4 * g4 + 1] * inv * pg8::u8f(gav[g4], 1)); w.y = cvt_pk_bf16(o[4 * g4 + 2] * inv * pg8::u8f(gav[g4], 2), o[4 * g4 + 3] * inv * pg8::u8f(gav[g4], 3));
                *(u32x2*)(P.ATT + qrow * 4096 + hq * 128 + 32 * db + 8 * g4 + 4 * h) = w; }
        }
    }
    __syncthreads();
}

constexpr int SSM_L = 512, SSM_NSC = SEQ / SSM_L;
constexpr int SSM_WL = 16640;
static_assert(NWAVES * SSM_WL <= MISC_OFF, "ssm LDS");
__device__ __forceinline__ void split_bf16(const f32x4 a, const f32x4 b, bf16x8& hi, bf16x8& lo) {
    u32x4 wh; wh.x = cvt_pk_bf16(a[0], a[1]); wh.y = cvt_pk_bf16(a[2], a[3]); wh.z = cvt_pk_bf16(b[0], b[1]); wh.w = cvt_pk_bf16(b[2], b[3]);
    f32x4 ra, rb; ra[0] = a[0] - pg8::bf_lo(wh.x); ra[1] = a[1] - pg8::bf_hi(wh.x); ra[2] = a[2] - pg8::bf_lo(wh.y); ra[3] = a[3] - pg8::bf_hi(wh.y);
    rb[0] = b[0] - pg8::bf_lo(wh.z); rb[1] = b[1] - pg8::bf_hi(wh.z); rb[2] = b[2] - pg8::bf_lo(wh.w); rb[3] = b[3] - pg8::bf_hi(wh.w);
    u32x4 wl; wl.x = cvt_pk_bf16(ra[0], ra[1]); wl.y = cvt_pk_bf16(ra[2], ra[3]); wl.z = cvt_pk_bf16(rb[0], rb[1]); wl.w = cvt_pk_bf16(rb[2], rb[3]);
    hi = __builtin_bit_cast(bf16x8, wh); lo = __builtin_bit_cast(bf16x8, wl);
}
template <bool PASS2> __device__ __forceinline__ void ssm_unit(const Ptrs& P, int sc, int g, LAS unsigned char* wl, int lane) {
    const int p = lane, fr = lane & 15, fq = lane >> 4;
    LAS float* R = (LAS float*)wl;
    const float dt = expf(P.log_dt[g]);
    const float lr = P.lam_re[g * NST + p], li = P.lam_im[g * NST + p];
    const float mag = expf(lr * dt), ar = mag * cosf(li * dt), ai = mag * sinf(li * dt);
    const float den = lr * lr + li * li, nr = ar - 1.0f;
    const float cre = (nr * lr + ai * li) / den, cim = (ai * lr - nr * li) / den;
#pragma unroll
    for (int q = 0; q < 4; ++q) { const f32x4 br = *(const f32x4*)(P.b_re + (size_t)(g * NST + p) * 16 + 4 * q), bi = *(const f32x4*)(P.b_im + (size_t)(g * NST + p) * 16 + 4 * q);
        *(LAS f32x4*)(R + p * 20 + 4 * q) = br * cre - bi * cim; *(LAS f32x4*)(R + (64 + p) * 20 + 4 * q) = bi * cre + br * cim; }
    LDS_WAIT();
    bf16x8 bhi[8], blo[8];
#pragma unroll
    for (int j = 0; j < 8; ++j) { const f32x4 a = *(const LAS f32x4*)(R + (16 * j + fr) * 20 + 8 * (fq & 1)), b = *(const LAS f32x4*)(R + (16 * j + fr) * 20 + 8 * (fq & 1) + 4);
        split_bf16(a, b, bhi[j], blo[j]); if (fq >= 2) blo[j] = (bf16x8){0, 0, 0, 0, 0, 0, 0, 0}; }
    LDS_WAIT();
    float sr = 0.f, si = 0.f;
    bf16x8 chi[4], clo[4]; f32x4 dv = {0.f, 0.f, 0.f, 0.f};
    if (PASS2) {
        float pr = ar, pi = ai;
#pragma unroll
        for (int k = 0; k < 9; ++k) { const float t = pr * pr - pi * pi; pi = 2.0f * pr * pi; pr = t; }
        const f32x2* Fp = (const f32x2*)P.F + (size_t)g * NST + p;
        for (int c0 = 0; c0 < sc; c0 += 8) {
            f32x2 f[8];
#pragma unroll
            for (int k = 0; k < 8; ++k) { f[k] = (f32x2){0.f, 0.f}; if (c0 + k < sc) f[k] = Fp[(size_t)(c0 + k) * NGRP * NST]; }
#pragma unroll
            for (int k = 0; k < 8; ++k) if (c0 + k < sc) { const float t = pr * sr - pi * si + f[k][0]; si = pr * si + pi * sr + f[k][1]; sr = t; }
        }
#pragma unroll
        for (int kk = 0; kk < 4; ++kk) { const float* cp = (kk < 2 ? P.c_re : P.c_im) + (size_t)(g * 16 + fr) * NST + 32 * (kk & 1) + 8 * fq;
            f32x4 a = *(const f32x4*)cp, b = *(const f32x4*)(cp + 4); if (kk >= 2) { a = -a; b = -b; }
            split_bf16(a, b, chi[kk], clo[kk]); }
        dv = *(const f32x4*)(P.dsk + 16 * g + 4 * fq);
    }
    const bf16* up = P.U + (size_t)(SSM_L * sc + fr) * SSMW + 16 * g;
    u32x4 uab = *(const u32x4*)(up + 8 * (fq & 1)); u32x2 uc = {0u, 0u};
    if (PASS2) uc = *(const u32x2*)(up + 4 * fq);
#pragma unroll 1
    for (int sb = 0; sb < SSM_L / 16; ++sb) {
        const bf16x8 af = fq < 2 ? __builtin_bit_cast(bf16x8, uab) : (bf16x8){0, 0, 0, 0, 0, 0, 0, 0};
        const f32x4 ucur = {pg8::bf_lo(uc.x), pg8::bf_hi(uc.x), pg8::bf_lo(uc.y), pg8::bf_hi(uc.y)};
        if (sb + 1 < SSM_L / 16) { const bf16* un = up + (size_t)(16 * (sb + 1)) * SSMW;
            uab = *(const u32x4*)(un + 8 * (fq & 1)); if (PASS2) uc = *(const u32x2*)(un + 4 * fq); }
#pragma unroll
        for (int j = 0; j < 8; ++j) { f32x4 d = {0.f, 0.f, 0.f, 0.f}; d = MFMA16(af, bhi[j], d); d = MFMA16(af, blo[j], d); *(LAS f32x4*)(R + (16 * j + fr) * 20 + 4 * fq) = d; }
        LDS_WAIT();
        f32x4 bre[4], bim[4];
#pragma unroll
        for (int q = 0; q < 4; ++q) { bre[q] = *(const LAS f32x4*)(R + p * 20 + 4 * q); bim[q] = *(const LAS f32x4*)(R + (64 + p) * 20 + 4 * q); }
        LDS_WAIT();
#pragma unroll
        for (int q = 0; q < 4; ++q)
#pragma unroll
            for (int x = 0; x < 4; ++x) { const float nsr = ar * sr - ai * si + bre[q][x], nsi = ar * si + ai * sr + bim[q][x]; sr = nsr; si = nsi;
                if (PASS2) { R[(4 * q + x) * 132 + p] = sr; R[(4 * q + x) * 132 + 64 + p] = si; } }
        if (PASS2) {
            LDS_WAIT();
            f32x4 y = {0.f, 0.f, 0.f, 0.f};
#pragma unroll
            for (int kk = 0; kk < 4; ++kk) { const f32x4 a = *(const LAS f32x4*)(R + fr * 132 + 32 * kk + 8 * fq), b = *(const LAS f32x4*)(R + fr * 132 + 32 * kk + 8 * fq + 4);
                bf16x8 shi, slo; split_bf16(a, b, shi, slo);
                y = MFMA16(chi[kk], shi, y); y = MFMA16(chi[kk], slo, y); y = MFMA16(clo[kk], shi, y); }
            y = y + dv * ucur;
            f32x4 o;
#pragma unroll
            for (int j = 0; j < 4; ++j) { const float v = y[j], z = 0.7978845608028654f * (v + 0.044715f * v * v * v); o[j] = v * __builtin_amdgcn_rcpf(1.0f + __builtin_amdgcn_exp2f(-2.0f * LOG2E * z)); }
            *(unsigned*)((unsigned char*)P.YG + (size_t)(SSM_L * sc + 16 * sb + fr) * SSMW + 16 * g + 4 * fq) = pg8::pk4_fp8(o[0], o[1], o[2], o[3]);
            LDS_WAIT();
        }
    }
    if (!PASS2) ((f32x2*)P.F)[(size_t)(sc * NGRP + g) * NST + p] = (f32x2){sr, si};
    LDS_WAIT();
}

struct Args { const void* in[23]; float* out; unsigned char* ws; };
__global__ void __launch_bounds__(NTHR, 2) mk_fwd(Args args) {
    extern __shared__ __attribute__((aligned(16))) unsigned char lds_raw[];
    LAS unsigned char* lds = (LAS unsigned char*)lds_raw;
    volatile LAS unsigned* MISC = (volatile LAS unsigned*)(lds + MISC_OFF);
    const int G = gridDim.x, bx = blockIdx.x;
#define FRESH_IDS() int lane = xb_lane_id(); asm volatile("" : "+v"(lane)); const int wave = bar.wave, tid = wave * 64 + lane; (void)tid
#define MAKE_PTRS() \
    const __attribute__((address_space(4))) Args* ap_ = (const __attribute__((address_space(4))) Args*)__builtin_amdgcn_kernarg_segment_ptr(); asm volatile("" : "+s"(ap_)); \
    unsigned char* ws = ap_->ws; Ptrs P; \
    P.x = (const float*)ap_->in[0]; P.c = (const float*)ap_->in[1]; P.pos = (const int*)ap_->in[2]; P.w_ada = (const float*)ap_->in[3]; P.b_ada = (const float*)ap_->in[4]; \
    P.n1g = (const float*)ap_->in[5]; P.n2g = (const float*)ap_->in[6]; P.w_in = (const float*)ap_->in[7]; P.qng = (const float*)ap_->in[8]; P.kng = (const float*)ap_->in[9]; \
    P.sinks = (const float*)ap_->in[10]; P.lam_re = (const float*)ap_->in[11]; P.lam_im = (const float*)ap_->in[12]; P.log_dt = (const float*)ap_->in[13]; \
    P.b_re = (const float*)ap_->in[14]; P.b_im = (const float*)ap_->in[15]; P.c_re = (const float*)ap_->in[16]; P.c_im = (const float*)ap_->in[17]; P.dsk = (const float*)ap_->in[18]; \
    P.w_glu = (const float*)ap_->in[19]; P.w_out = (const float*)ap_->in[20]; P.w_ff1 = (const float*)ap_->in[21]; P.w_ff2 = (const float*)ap_->in[22]; \
    P.out = ap_->out; \
    P.MODP = (float*)(ws + WS_MODP); P.MOD = (float*)(ws + WS_MOD); P.ROPE = (float*)(ws + WS_ROPE); P.F = (float*)(ws + WS_F); P.U = (bf16*)(ws + WS_U); P.BIAS2 = (float*)(ws + WS_BIAS2); P.SSQ = (float*)(ws + WS_SSQ); \
    P.H8 = ws + WS_H8; P.WG8 = ws + WS_WG8; P.WINU = (bf16*)(ws + WS_WINU); P.HI8 = ws + WS_HI8; P.MRGI8 = ws + WS_MRGI8; P.MMAX = (float*)(ws + WS_MMAX); P.SAH = (float*)(ws + WS_SAH); P.SAM = (float*)(ws + WS_SAM); P.WMAXU = (unsigned*)(ws + WS_WMAXU); P.WMAXO = (unsigned*)(ws + WS_WMAXO); P.WIN = (bf16*)(ws + WS_WIN); P.WGLU = (bf16*)(ws + WS_WGLU); P.WOUT = (bf16*)(ws + WS_WOUT); P.WFF1 = (bf16*)(ws + WS_WFF1); P.WFF2 = (bf16*)(ws + WS_WFF2); \
    P.H = (bf16*)(ws + WS_H); P.Q = (bf16*)(ws + WS_Q); P.K = (bf16*)(ws + WS_K); P.V = (bf16*)(ws + WS_V); P.GA = (unsigned char*)(ws + WS_GA); P.GS = (unsigned char*)(ws + WS_GS); \
    P.ATT = (bf16*)(ws + WS_ATT); P.YG = (bf16*)(ws + WS_YG); P.MRG = ws + WS_MRG; P.FFH = (bf16*)(ws + WS_FFH); (void)ws

    for (int u = threadIdx.x; u < (LDS_BYTES - MISC_OFF) / 4; u += NTHR) MISC[u] = 0u;
    __syncthreads();
    XcdBarrier bar; { gu32* ctl = (gu32*)(args.ws + WS_CTL); bar = xcd_barrier_post((unsigned*)(ctl + CW_BAR), MISC + 8); }

    { MAKE_PTRS(); FRESH_IDS(); phase0(P, lds, bx, G, tid, wave, lane); }
    xcd_barrier(bar);
    { MAKE_PTRS(); FRESH_IDS(); phase1(P, lds, bx, G, tid, wave, lane); }
    xcd_barrier(bar);
    {
        MAKE_PTRS();
        pg8::Gemm g{(const bf16*)P.H8, (const bf16*)P.WG8, SEQ, 14336, DM / 2}; pg8::StaticOrder S; S.init(SEQ, 14336, G, bx);
        pg8::EpiProj E{P.Q, P.K, P.V, P.GA, P.GS, P.qng, P.kng, P.ROPE, (PG8_LAS float*)(lds + XCH_OFF)};
        pg8::gemm_phase<pg8::EpiProj, pg8::StaticOrder, true, true, true>(lds, g, S, E, bar.wave);
    }
    {
        MAKE_PTRS();
        pg8::Gemm g{(const bf16*)P.HI8, P.WINU, SEQ, 2048, DM / 2}; pg8::StaticOrder S; S.init(SEQ, 2048, G, bx);
        pg8::EpiU E{P.U, P.SAH, P.WMAXU};
        pg8::gemm_phase<pg8::EpiU, pg8::StaticOrder, true, true, false, true>(lds, g, S, E, bar.wave);
    }
    xcd_barrier(bar);
    constexpr int TI_P3 = 18432;
    {
        MAKE_PTRS(); FRESH_IDS();
        for (int u = bx; u < 64 * NKVH; u += G) attn_unit(P, u >> 3, u & 7, lds, tid, wave, lane);
        if (wave < 4) { const int gw4 = bx * 4 + wave, NGW4 = G * 4;
            for (int id = gw4; id < SSM_NSC * NGRP; id += NGW4) ssm_unit<false>(P, id >> 7, id & 127, lds + wave * SSM_WL, lane); }
        const int per = (TI_P3 + G - 1) / G, lo = bx * per, hi = (lo + per < TI_P3) ? lo + per : TI_P3;
        transpose_pool<1>(P, lo, hi, (LAS unsigned*)(lds + MISC_OFF) + 16, (LAS float*)(lds + wave * SSM_WL), lane);
    }
    xcd_barrier(bar);
    {
        MAKE_PTRS(); FRESH_IDS();
        if (wave < 4) { const int gw4 = bx * 4 + wave, NGW4 = G * 4;
            for (int id = gw4; id < SSM_NSC * NGRP; id += NGW4) ssm_unit<true>(P, id >> 7, id & 127, lds + wave * SSM_WL, lane); }
        const int per = (TI_ALL - TI_P3 + G - 1) / G, lo = TI_P3 + bx * per, hi = (lo + per < TI_ALL) ? lo + per : TI_ALL;
        transpose_pool<1>(P, lo, hi, (LAS unsigned*)(lds + MISC_OFF) + 17, (LAS float*)(lds + wave * SSM_WL), lane);
    }
    xcd_barrier(bar);
    {
        MAKE_PTRS();
        pg8::Gemm g{P.YG, P.WGLU, SEQ, 2 * DM, SSMW / 2}; pg8::StaticOrder S; S.init(SEQ, 2 * DM, G, bx);
        pg8::EpiGlu E{P.GS, P.ATT, P.MRG, P.MMAX};
        pg8::gemm_phase<pg8::EpiGlu, pg8::StaticOrder, true, true, true>(lds, g, S, E, bar.wave);
    }
    xcd_barrier(bar);
    {
        MAKE_PTRS(); FRESH_IDS();
        const int gw = bx * NWAVES + wave, NGW = G * NWAVES;
        for (int row = gw; row < SEQ; row += NGW) quant_row(P.MRG + (size_t)row * DM, P.MMAX + (size_t)row * 128, P.MRGI8 + (size_t)row * DM, P.SAM + row, lane);
    }
    xcd_barrier(bar);
    {
        MAKE_PTRS();
        pg8::Gemm g{(const bf16*)P.MRGI8, P.WOUT, SEQ, DM, DM / 2}; pg8::StaticOrder S; S.init(SEQ, DM, G, bx);
        pg8::EpiResid<true> E{P.x, nullptr, nullptr, P.MOD + 2 * DM, P.H, P.SSQ, P.SAM, P.WMAXO};
        pg8::gemm_phase<pg8::EpiResid<true>, pg8::StaticOrder, true, true, false, true>(lds, g, S, E, bar.wave);
    }
    xcd_barrier(bar);
    {
        MAKE_PTRS();
        pg8::Gemm g{P.H, P.WFF1, SEQ, DFF, DM}; pg8::StaticOrder S; S.init(SEQ, DFF, G, bx);
        LAS float* rst = (LAS float*)(lds + XCH_OFF);
        { pg8::Unit u0, ui; S.next(0, u0); bool same = true; for (int i = 1; S.next(i, ui); ++i) same = same && (ui.pm == u0.pm);
          FRESH_IDS(); const int t = tid;
          if (t < 256) { const f32x4* sp = (const f32x4*)(P.SSQ + (size_t)(u0.pm * 256 + t) * 64); f32x4 a = {0.f, 0.f, 0.f, 0.f};
#pragma unroll
              for (int q = 0; q < 16; ++q) a += sp[q];
              const float s = (a[0] + a[1]) + (a[2] + a[3]);
              rst[t] = same ? 1.0f / sqrtf(s * (1.0f / DM) + EPS) : __builtin_nanf(""); }
          __syncthreads(); }
        pg8::EpiRelu2<true> E{P.FFH, DFF, rst, P.BIAS2};
        pg8::gemm_phase<pg8::EpiRelu2<true>, pg8::StaticOrder, true, true>(lds, g, S, E, bar.wave);
    }
    xcd_barrier(bar);
    {
        MAKE_PTRS();
        pg8::Gemm g{P.FFH, P.WFF2, SEQ, DM, DFF}; pg8::StaticOrder S; S.init(SEQ, DM, G, bx);
        pg8::EpiResid<false> E{nullptr, P.H, P.out, P.MOD + 5 * DM, nullptr, nullptr, nullptr, nullptr};
        pg8::gemm_phase<pg8::EpiResid<false>, pg8::StaticOrder, true, true>(lds, g, S, E, bar.wave);
    }
}

extern "C" void kernel_launch(void* const* d_in, const int* in_sizes, int n_in, void* d_out, int out_size, void* d_ws, size_t ws_size, hipStream_t stream) {
    static int grid = 0;
    if (grid == 0) {
        if (n_in != 23 || in_sizes[0] != SEQ * DM || out_size != SEQ * DM || ws_size < WS_END) {
            fprintf(stderr, "kernel_launch: unexpected problem (n_in %d, in0 %d, out %d, ws %zu); nothing launched\n", n_in, n_in > 0 ? in_sizes[0] : -1, out_size, ws_size); grid = -1; return; }
        int dev = 0, cus = 0, per_cu = 0;
        if (hipGetDevice(&dev) != hipSuccess || hipDeviceGetAttribute(&cus, hipDeviceAttributeMultiprocessorCount, dev) != hipSuccess) { fprintf(stderr, "kernel_launch: device query failed\n"); grid = -1; return; }
        if (hipFuncSetAttribute((const void*)mk_fwd, hipFuncAttributeMaxDynamicSharedMemorySize, LDS_BYTES) != hipSuccess) { fprintf(stderr, "kernel_launch: hipFuncSetAttribute failed\n"); grid = -1; return; }
        if (hipOccupancyMaxActiveBlocksPerMultiprocessor(&per_cu, (const void*)mk_fwd, NTHR, LDS_BYTES) != hipSuccess || per_cu < 1)
            fprintf(stderr, "kernel_launch: note: occupancy query reports %d workgroups per CU\n", per_cu);
        (void)hipGetLastError();
        if (cus != 256) { fprintf(stderr, "kernel_launch: built for a 256-CU device (got %d CUs); nothing launched\n", cus); grid = -1; return; }
        grid = cus;
    }
    if (grid < 0) return;
    if (hipMemsetAsync((char*)d_ws + WS_CTL, 0, CTL_ZERO_BYTES, stream) != hipSuccess) { fprintf(stderr, "kernel_launch: memset failed\n"); return; }
    Args a{};
    for (int i = 0; i < 23; ++i) a.in[i] = d_in[i];
    a.out = (float*)d_out; a.ws = (unsigned char*)d_ws;
    hipLaunchKernelGGL(mk_fwd, dim3(grid), dim3(NTHR), LDS_BYTES, stream, a);
    const hipError_t le = hipPeekAtLastError();
    if (le != hipSuccess) fprintf(stderr, "kernel_launch: launch failed: %s\n", hipGetErrorName(le));
}
```
